# Optimizing an MI355X kernel written in HIP

```python
import math
import numpy as np
import jax, jax.numpy as jnp
from jax import lax

D_MODEL = 1024
BATCH = 2
SEQ = 8192
DEPTH = 1

D_MIX = D_MODEL
RET_HEADS = D_MODEL // 256
RET_QK_DIM = 128
RET_V_DIM = 128
RET_WIDTH = RET_HEADS * RET_V_DIM
RET_CHUNK = 128
MLA_HEADS = D_MODEL // 256
MLA_Q_RANK = 256
MLA_KV_RANK = 256
MLA_NOPE_DIM = 128
MLA_ROPE_DIM = 64
MLA_V_DIM = 128
MLA_WIDTH = MLA_HEADS * MLA_V_DIM
Q_BLOCK = 128
D_FF = 2816
CONV_WIDTH = 3
ROPE_BASE = 10000.0
LN_EPS = 1e-5
RMS_EPS = 1e-6
DN_ALPHA = (2.0 * DEPTH) ** 0.25
DN_BETA = (8.0 * DEPTH) ** -0.25
N_MOD = 6

IN_SIZES = [RET_HEADS * RET_QK_DIM,
            RET_HEADS * RET_QK_DIM,
            RET_HEADS * RET_V_DIM,
            RET_WIDTH,
            MLA_Q_RANK,
            MLA_KV_RANK,
            MLA_ROPE_DIM]
IN_DIM = sum(IN_SIZES)
IN_SPLITS = [int(s) for s in np.cumsum(IN_SIZES)[:-1]]

kernel_name = "hybrid_retention_mla_convffn_deepnorm_adaln"


def layer_norm_plain(x):
    xf = x.astype(jnp.float32)
    mu = jnp.mean(xf, axis=-1, keepdims=True)
    var = jnp.mean(jnp.square(xf - mu), axis=-1, keepdims=True)
    return ((xf - mu) * lax.rsqrt(var + LN_EPS)).astype(x.dtype)


def layer_norm(x, w, b):
    return layer_norm_plain(x) * w + b


def rms_norm(x, w):
    xf = x.astype(jnp.float32)
    y = xf * lax.rsqrt(jnp.mean(jnp.square(xf), axis=-1, keepdims=True) + RMS_EPS)
    return y.astype(x.dtype) * w


def rope(x, pos):
    half = x.shape[-1] // 2
    inv = ROPE_BASE ** (-jnp.arange(half, dtype=jnp.float32) / half)
    ang = pos[:, None] * inv[None, :]
    cos = jnp.cos(ang).astype(x.dtype)
    sin = jnp.sin(ang).astype(x.dtype)
    x1, x2 = x[..., :half], x[..., half:]
    return jnp.concatenate([x1 * cos - x2 * sin, x2 * cos + x1 * sin], axis=-1)


def retention(q, k, v):
    B, H, S, dk = q.shape
    dv = v.shape[-1]
    C = RET_CHUNK
    nC = S // C
    q = q.astype(jnp.float32).reshape(B, H, nC, C, dk)
    k = k.astype(jnp.float32).reshape(B, H, nC, C, dk)
    v = v.astype(jnp.float32).reshape(B, H, nC, C, dv)
    log_g = jnp.log1p(-(2.0 ** (-5.0 - jnp.arange(H, dtype=jnp.float32))))
    n = jnp.arange(C, dtype=jnp.float32)
    rel = n[:, None] - n[None, :]
    decay = jnp.where(rel >= 0, jnp.exp(log_g[:, None, None] * jnp.maximum(rel, 0.0)), 0.0)
    scores = jnp.einsum('bhcnd,bhcmd->bhcnm', q, k) * decay[None, :, None]
    inner = jnp.einsum('bhcnm,bhcme->bhcne', scores, v)
    k_w = jnp.exp(log_g[:, None] * (C - 1.0 - n)[None, :])
    chunk_kv = jnp.einsum('bhcmd,hm,bhcme->bhcde', k, k_w, v)
    chunk_decay = jnp.exp(log_g * C)[None, :, None, None]

    def step(state, kv):
        return state * chunk_decay + kv, state

    init = jnp.zeros((B, H, dk, dv), jnp.float32)
    _, prev = lax.scan(step, init, jnp.moveaxis(chunk_kv, 2, 0))
    prev = jnp.moveaxis(prev, 0, 2)
    q_w = jnp.exp(log_g[:, None] * (n + 1.0)[None, :])
    cross = jnp.einsum('bhcnd,bhcde,hn->bhcne', q, prev, q_w)
    return (inner + cross).reshape(B, H, S, dv)


def causal_block_attention(q, k, v):
    B, H, S, dq = q.shape
    nb = S // Q_BLOCK
    scale = dq ** -0.5
    qb = jnp.moveaxis(q.reshape(B, H, nb, Q_BLOCK, dq), 2, 0)
    key_pos = jnp.arange(S)

    def block(args):
        q_blk, start = args
        s = jnp.einsum('bhqd,bhkd->bhqk', q_blk, k).astype(jnp.float32) * scale
        q_pos = start + jnp.arange(Q_BLOCK)
        s = jnp.where(key_pos[None, :] <= q_pos[:, None], s, -jnp.inf)
        p = jax.nn.softmax(s, axis=-1).astype(v.dtype)
        return jnp.einsum('bhqk,bhkd->bhqd', p, v)

    out = lax.map(block, (qb, jnp.arange(nb) * Q_BLOCK))
    return jnp.moveaxis(out, 0, 2).reshape(B, H, S, v.shape[-1])


def token_mixer(h, w_in, ret_gn_w, mla_q_norm_w, w_uq, mla_kv_norm_w, w_ukv, w_out, pos):
    B, S, _ = h.shape
    proj = h @ w_in
    rq, rk, rv, rg, cq, ckv, kr = jnp.split(proj, IN_SPLITS, axis=-1)

    def heads(t, n_heads):
        return t.reshape(B, S, n_heads, -1).transpose(0, 2, 1, 3)

    rq = rope(heads(rq, RET_HEADS), pos)
    rk = rope(heads(rk, RET_HEADS), pos) * (RET_QK_DIM ** -0.5)
    ro = retention(rq, rk, heads(rv, RET_HEADS))
    mu = jnp.mean(ro, axis=-1, keepdims=True)
    var = jnp.mean(jnp.square(ro - mu), axis=-1, keepdims=True)
    ro = ((ro - mu) * lax.rsqrt(var + LN_EPS)).astype(h.dtype)
    ro = ro * ret_gn_w.reshape(RET_HEADS, 1, RET_V_DIM)
    ret_out = ro.transpose(0, 2, 1, 3).reshape(B, S, RET_WIDTH) * jax.nn.silu(rg)

    q = (rms_norm(cq, mla_q_norm_w) @ w_uq).reshape(B, S, MLA_HEADS, MLA_NOPE_DIM + MLA_ROPE_DIM)
    q = q.transpose(0, 2, 1, 3)
    q = jnp.concatenate([q[..., :MLA_NOPE_DIM], rope(q[..., MLA_NOPE_DIM:], pos)], axis=-1)
    kv = (rms_norm(ckv, mla_kv_norm_w) @ w_ukv).reshape(B, S, MLA_HEADS, MLA_NOPE_DIM + MLA_V_DIM)
    kv = kv.transpose(0, 2, 1, 3)
    k_nope, mv = kv[..., :MLA_NOPE_DIM], kv[..., MLA_NOPE_DIM:]
    k_rope = rope(kr[:, None], pos)
    k = jnp.concatenate([k_nope, jnp.broadcast_to(k_rope, (B, MLA_HEADS, S, MLA_ROPE_DIM))], axis=-1)
    mo = causal_block_attention(q, k, mv)
    mla_out = mo.transpose(0, 2, 1, 3).reshape(B, S, MLA_WIDTH)

    return jnp.concatenate([ret_out, mla_out], axis=-1) @ w_out


def conv_ffn(h, w_up, conv_w, conv_b, w_down):
    S = h.shape[1]
    u = h @ w_up
    up = jnp.pad(u, ((0, 0), (CONV_WIDTH - 1, 0), (0, 0)))
    u = conv_b + sum(up[:, j:j + S] * conv_w[j] for j in range(CONV_WIDTH))
    gate, val = jnp.split(u, 2, axis=-1)
    return (jax.nn.silu(gate) * val) @ w_down


def setup_inputs(seed: int = 0) -> dict:
    key = jax.random.key(seed)
    ks = jax.random.split(key, 20)
    L = DEPTH
    nrm = lambda k, shape, s: jax.random.normal(k, shape, jnp.float32) * s
    gain = lambda k, n: 1.0 + 0.02 * jax.random.normal(k, (L, n), jnp.float32)

    in_scale = jnp.concatenate([jnp.ones((IN_SPLITS[1],), jnp.float32),
                                jnp.full((IN_SIZES[2],), DN_BETA, jnp.float32),
                                jnp.ones((IN_DIM - IN_SPLITS[2],), jnp.float32)])
    ukv_scale = jnp.tile(jnp.concatenate([jnp.ones((MLA_NOPE_DIM,), jnp.float32),
                                          jnp.full((MLA_V_DIM,), DN_BETA, jnp.float32)]), MLA_HEADS)
    return {
        "x": nrm(ks[0], (BATCH, SEQ, D_MODEL), 1.0),
        "c": nrm(ks[1], (BATCH, D_MODEL), 1.0),
        "w_ada": nrm(ks[2], (L, D_MODEL, N_MOD * D_MODEL), 0.2 * D_MODEL ** -0.5),
        "b_ada": nrm(ks[3], (L, N_MOD * D_MODEL), 0.01),
        "w_in": nrm(ks[4], (L, D_MODEL, IN_DIM), D_MODEL ** -0.5) * in_scale,
        "ret_gn_w": gain(ks[5], RET_WIDTH),
        "mla_q_norm_w": gain(ks[6], MLA_Q_RANK),
        "w_uq": nrm(ks[7], (L, MLA_Q_RANK, MLA_HEADS * (MLA_NOPE_DIM + MLA_ROPE_DIM)), MLA_Q_RANK ** -0.5),
        "mla_kv_norm_w": gain(ks[8], MLA_KV_RANK),
        "w_ukv": nrm(ks[9], (L, MLA_KV_RANK, MLA_HEADS * (MLA_NOPE_DIM + MLA_V_DIM)), MLA_KV_RANK ** -0.5) * ukv_scale,
        "w_out": nrm(ks[10], (L, D_MIX, D_MODEL), DN_BETA * D_MIX ** -0.5),
        "ln1_w": gain(ks[11], D_MODEL),
        "ln1_b": nrm(ks[12], (L, D_MODEL), 0.02),
        "w_up": nrm(ks[13], (L, D_MODEL, 2 * D_FF), D_MODEL ** -0.5),
        "conv_w": nrm(ks[14], (L, CONV_WIDTH, 2 * D_FF), CONV_WIDTH ** -0.5),
        "conv_b": nrm(ks[15], (L, 2 * D_FF), 0.02),
        "w_down": nrm(ks[16], (L, D_FF, D_MODEL), DN_BETA * D_FF ** -0.5),
        "ln2_w": gain(ks[17], D_MODEL),
        "ln2_b": nrm(ks[18], (L, D_MODEL), 0.02),
    }


def reference(x, c, w_ada, b_ada, w_in, ret_gn_w, mla_q_norm_w, w_uq, mla_kv_norm_w, w_ukv,
              w_out, ln1_w, ln1_b, w_up, conv_w, conv_b, w_down, ln2_w, ln2_b):
    S = x.shape[1]
    pos = jnp.arange(S, dtype=jnp.float32)
    cond = jax.nn.silu(c)
    for l in range(DEPTH):
        mod = (cond @ w_ada[l] + b_ada[l])[:, None, :]
        sh1, sc1, g1, sh2, sc2, g2 = jnp.split(mod, N_MOD, axis=-1)
        h = layer_norm_plain(x) * (1.0 + sc1) + sh1
        y = token_mixer(h, w_in[l], ret_gn_w[l], mla_q_norm_w[l], w_uq[l], mla_kv_norm_w[l],
                        w_ukv[l], w_out[l], pos)
        x = layer_norm(DN_ALPHA * x + (1.0 + g1) * y, ln1_w[l], ln1_b[l])
        h = layer_norm_plain(x) * (1.0 + sc2) + sh2
        y = conv_ffn(h, w_up[l], conv_w[l], conv_b[l], w_down[l])
        x = layer_norm(DN_ALPHA * x + (1.0 + g2) * y, ln2_w[l], ln2_b[l])
    return x
```

```cpp
#include <hip/hip_runtime.h>
#include <hip/hip_cooperative_groups.h>
#include <cstdio>
#include <cstdint>
#include <cmath>
namespace cg = cooperative_groups;

namespace pg8 {
#define PG8_LAS __attribute__((address_space(3)))
typedef unsigned short bf16_t;
typedef short bf16x8 __attribute__((ext_vector_type(8)));
typedef float f32x4 __attribute__((ext_vector_type(4)));
typedef unsigned u32x4 __attribute__((ext_vector_type(4)));
typedef unsigned u32x2 __attribute__((ext_vector_type(2)));
constexpr int BM = 256, BK = 64, HALF = 128, HTB = HALF * BK * 2  , STAGE_BYTES = 8 * HTB, NXCD = 8, WGM = 8;

__host__ __device__ __forceinline__ int lds_byte(int r, int c) { const int st = (r >> 4) * 2 + (c >> 5), rr = r & 15, cc = c & 31, ob = rr * 64 + cc * 2; return st * 1024 + (ob ^ (((ob >> 9) & 1) << 5)); }
__host__ __device__ __forceinline__ void stage_rc(int b, int& R, int& C) { const int st = b / 1024, sb = b % 1024, swz = sb ^ (((sb >> 9) & 1) << 5); R = (st >> 1) * 16 + swz / 64; C = (st & 1) * 32 + (swz % 64) / 2; }
__host__ __device__ __forceinline__ int perm32(int rho) { const int n = rho >> 4, i = rho & 15; return 8 * (i >> 2) + 4 * n + (i & 3); }

struct Unit { int pm, pn; };
struct Gemm { const bf16_t* A; const bf16_t* Bt; int M, N, K; };

struct StaticOrder {
    int nM, nN, nwg, G, c;
    __host__ __device__ void init(int M, int N, int G_, int c_) { nM = M / BM; nN = N / BM; nwg = nM * nN; G = G_; c = c_; }
    __host__ __device__ bool next(int i, Unit& u) const {
        const long L = (long)i * G + c; if (L >= nwg) return false;
        int wgid = (int)L; { const int q = nwg / NXCD, r = nwg % NXCD, xcd = wgid % NXCD, off = wgid / NXCD; wgid = (xcd < r ? xcd * (q + 1) : r * (q + 1) + (xcd - r) * q) + off; }
        const int nig = WGM * nN, gid = wgid / nig, fm = gid * WGM, gsz = (nM - fm) < WGM ? (nM - fm) : WGM;
        u.pm = fm + ((wgid % nig) % gsz); u.pn = (wgid % nig) / gsz; return true;
    }
    __device__ __forceinline__ void a_ready(const Unit&) const {}
    __device__ __forceinline__ void done(const Unit&) const {}
};
__device__ __forceinline__ unsigned cvt_pk_bf16(float lo, float hi) { unsigned r; asm volatile("v_cvt_pk_bf16_f32 %0, %1, %2" : "=v"(r) : "v"(lo), "v"(hi)); return r; }
template <class Epi, class Sched, bool ALIGN_EPI = false, bool SP2 = false, bool AMAP = false>
__device__ __forceinline__ void gemm_phase(PG8_LAS unsigned char* lds, const Gemm g, const Sched& S, const Epi& E) {
    const int tid = threadIdx.x, wid = __builtin_amdgcn_readfirstlane(tid >> 6), lane = tid & 63, wr = wid >> 2, wc = wid & 3, fr = lane & 15, fq = lane >> 4;
    const int K = g.K, nt = K / BK;
    unsigned voffA[2], voffB[2];
#pragma unroll
    for (int i = 0; i < 2; ++i) { int R, C; stage_rc(tid * 16 + i * 8192, R, C); const int Rb = Epi::PERM ? ((R & ~31) + perm32(R & 31)) : R;
        const int Ra = AMAP ? ((R >> 6) * 126 + (R & 15) * 8 + ((R >> 4) & 3)) : R; voffA[i] = (unsigned)(Ra * K + C) * 2u; voffB[i] = (unsigned)(Rb * K + C) * 2u; }
    const size_t kstep = (size_t)(BK * 2);
    const size_t hstep = (size_t)HALF * K * 2;
    const size_t tstep = 2 * hstep;
    const size_t hstepA = AMAP ? (size_t)4 * K * 2 : hstep, tstepA = AMAP ? (size_t)252 * K * 2 : tstep;
    const unsigned ldsw = (unsigned)wid * 1024u;
    const int aoff = lds_byte(wr * 64 + fr, fq * 8), boff = lds_byte(wc * 32 + fr, fq * 8);
#define PG8_SA(b, h) (((b) * 2 + (h)) * HTB)
#define PG8_SB(b, h) ((4 + (b) * 2 + (h)) * HTB)
#define PG8_STAGE(bufoff, gbase, voff) do { _Pragma("unroll") for (int _i = 0; _i < 2; ++_i) \
        __builtin_amdgcn_global_load_lds((const unsigned*)((const char*)(gbase) + (voff)[_i]), (PG8_LAS unsigned*)(lds + (bufoff) + ldsw + _i * 8192), 16, 0, 0); } while (0)
#define PG8_LDA(dst, b, h) do { _Pragma("unroll") for (int m = 0; m < 4; ++m) _Pragma("unroll") for (int k = 0; k < 2; ++k) dst[m][k] = *(const PG8_LAS bf16x8*)(lds + PG8_SA(b, h) + aoff + m * 2048 + k * 1024); } while (0)
#define PG8_LDB(dst, b, h) do { _Pragma("unroll") for (int n = 0; n < 2; ++n) _Pragma("unroll") for (int k = 0; k < 2; ++k) dst[n][k] = *(const PG8_LAS bf16x8*)(lds + PG8_SB(b, h) + boff + n * 2048 + k * 1024); } while (0)
#define PG8_MMA(ai, bj, At, Bt) do { __builtin_amdgcn_s_setprio(1); _Pragma("unroll") for (int m = 0; m < 4; ++m) _Pragma("unroll") for (int n = 0; n < 2; ++n) _Pragma("unroll") for (int k = 0; k < 2; ++k) \
        acc[ai][bj][m][n] = __builtin_amdgcn_mfma_f32_16x16x32_bf16(Bt[n][k], At[m][k], acc[ai][bj][m][n], 0, 0, 0); __builtin_amdgcn_s_setprio(0); } while (0)
#define PG8_WAIT_V(n) asm volatile("s_waitcnt vmcnt(" #n ")" ::: "memory")
#define PG8_WAIT_L(n) asm volatile("s_waitcnt lgkmcnt(" #n ")" ::: "memory")
#define PG8_BAR __builtin_amdgcn_s_barrier()
#define PG8_SCHED __builtin_amdgcn_sched_barrier(0)
    Unit cur, nxt; int ui = 0;
    if (!S.next(0, cur)) return;
    f32x4 acc[2][2][4][2];
#pragma unroll
    for (int a = 0; a < 2; ++a)
#pragma unroll
        for (int b = 0; b < 2; ++b)
#pragma unroll
            for (int m = 0; m < 4; ++m)
#pragma unroll
                for (int n = 0; n < 2; ++n) acc[a][b][m][n] = (f32x4){0.f, 0.f, 0.f, 0.f};
    bf16x8 At[4][2], B0[2][2], B1[2][2];
    const char* cA = (const char*)g.A + (size_t)cur.pm * tstepA; const char* cB = (const char*)g.Bt + (size_t)cur.pn * tstep;
    S.a_ready(cur);
    if constexpr (SP2) {
        PG8_STAGE(PG8_SB(0, 0), cB, voffB); PG8_STAGE(PG8_SB(0, 1), cB + hstep, voffB); PG8_STAGE(PG8_SA(0, 0), cA, voffA); PG8_STAGE(PG8_SA(0, 1), cA + hstepA, voffA);
        if (wr == 1) PG8_BAR;
        PG8_WAIT_V(2); PG8_BAR;
        PG8_STAGE(PG8_SB(1, 0), cB + kstep, voffB); PG8_STAGE(PG8_SA(1, 0), cA + kstep, voffA); PG8_STAGE(PG8_SB(1, 1), cB + hstep + kstep, voffB);
        PG8_WAIT_V(6); PG8_BAR;
    } else {
        PG8_STAGE(PG8_SB(0, 0), cB, voffB); PG8_STAGE(PG8_SA(0, 0), cA, voffA); PG8_STAGE(PG8_SB(0, 1), cB + hstep, voffB); PG8_STAGE(PG8_SA(0, 1), cA + hstepA, voffA);
        if (wr == 1) PG8_BAR;
        PG8_WAIT_V(4); PG8_BAR;
        PG8_STAGE(PG8_SB(1, 0), cB + kstep, voffB); PG8_STAGE(PG8_SA(1, 0), cA + kstep, voffA); PG8_STAGE(PG8_SB(1, 1), cB + hstep + kstep, voffB);
        PG8_WAIT_V(6); PG8_BAR;
    }
    for (;;) {
        const bool has_next = S.next(ui + 1, nxt);
        const char* nA = has_next ? (const char*)g.A + (size_t)nxt.pm * tstepA : cA; const char* nB = has_next ? (const char*)g.Bt + (size_t)nxt.pn * tstep : cB;
#pragma unroll 1
        for (int t = 0; t < nt; t += 2) {
            const bool last = (t == nt - 2);
            const char* a1 = cA + (size_t)(t + 1) * kstep;
            const char* a2 = last ? nA : cA + (size_t)(t + 2) * kstep; const char* b2 = last ? nB : cB + (size_t)(t + 2) * kstep;
            const char* a3 = a2 + kstep; const char* b3 = b2 + kstep;
            if (last && has_next) S.a_ready(nxt);
            if constexpr (SP2) {
            PG8_LDB(B0, 0, 0); PG8_LDB(B1, 0, 1); PG8_SCHED; PG8_LDA(At, 0, 0); PG8_STAGE(PG8_SA(1, 1), a1 + hstepA, voffA);
            PG8_WAIT_V(8); PG8_WAIT_L(0); PG8_BAR; PG8_MMA(0, 0, At, B0); PG8_MMA(0, 1, At, B1); PG8_BAR; PG8_SCHED;
            PG8_LDA(At, 0, 1); PG8_STAGE(PG8_SB(0, 0), b2, voffB); PG8_STAGE(PG8_SB(0, 1), b2 + hstep, voffB); PG8_STAGE(PG8_SA(0, 0), a2, voffA);
            PG8_WAIT_V(8); PG8_WAIT_L(0); PG8_BAR; PG8_MMA(1, 0, At, B0); PG8_MMA(1, 1, At, B1); PG8_BAR; PG8_SCHED;
            PG8_LDB(B0, 1, 0); PG8_LDB(B1, 1, 1); PG8_SCHED; PG8_LDA(At, 1, 0); PG8_STAGE(PG8_SA(0, 1), a2 + hstepA, voffA);
            PG8_WAIT_V(8); PG8_WAIT_L(0); PG8_BAR; PG8_MMA(0, 0, At, B0); PG8_MMA(0, 1, At, B1); PG8_BAR; PG8_SCHED;
            PG8_LDA(At, 1, 1); PG8_STAGE(PG8_SB(1, 0), b3, voffB); PG8_STAGE(PG8_SB(1, 1), b3 + hstep, voffB); PG8_STAGE(PG8_SA(1, 0), a3, voffA);
            PG8_WAIT_V(8); PG8_WAIT_L(0); PG8_BAR; PG8_MMA(1, 0, At, B0); PG8_MMA(1, 1, At, B1); PG8_BAR; PG8_SCHED;
            } else {
            PG8_LDB(B0, 0, 0); PG8_SCHED; PG8_LDA(At, 0, 0); PG8_STAGE(PG8_SA(1, 1), a1 + hstepA, voffA);
            PG8_WAIT_L(8); PG8_BAR; PG8_WAIT_L(0); PG8_MMA(0, 0, At, B0); PG8_BAR; PG8_SCHED;
            PG8_LDB(B1, 0, 1); PG8_STAGE(PG8_SB(0, 0), b2, voffB);
            PG8_BAR; PG8_WAIT_L(0); PG8_MMA(0, 1, At, B1); PG8_BAR;
            PG8_LDA(At, 0, 1); PG8_STAGE(PG8_SA(0, 0), a2, voffA);
            PG8_BAR; PG8_WAIT_L(0); PG8_MMA(1, 0, At, B0); PG8_BAR; PG8_SCHED;
            PG8_STAGE(PG8_SB(0, 1), b2 + hstep, voffB);
            PG8_WAIT_V(6); PG8_BAR; PG8_MMA(1, 1, At, B1); PG8_BAR;
            PG8_LDB(B0, 1, 0); PG8_SCHED; PG8_LDA(At, 1, 0); PG8_STAGE(PG8_SA(0, 1), a2 + hstepA, voffA);
            PG8_WAIT_L(8); PG8_BAR; PG8_WAIT_L(0); PG8_MMA(0, 0, At, B0); PG8_BAR; PG8_SCHED;
            PG8_LDB(B1, 1, 1); PG8_STAGE(PG8_SB(1, 0), b3, voffB);
            PG8_BAR; PG8_WAIT_L(0); PG8_MMA(0, 1, At, B1); PG8_BAR;
            PG8_LDA(At, 1, 1); PG8_STAGE(PG8_SA(1, 0), a3, voffA);
            PG8_BAR; PG8_WAIT_L(0); PG8_MMA(1, 0, At, B0); PG8_BAR; PG8_SCHED;
            PG8_STAGE(PG8_SB(1, 1), b3 + hstep, voffB);
            PG8_WAIT_V(6); PG8_BAR; PG8_MMA(1, 1, At, B1); PG8_BAR;
            }
        }
        if constexpr (ALIGN_EPI) { if (wr == 0) PG8_BAR; }
        if constexpr (!Epi::AFTER_DRAIN) { E(acc, cur, wr, wc, fr, fq); S.done(cur); }
        if (!has_next) break;
#pragma unroll
        for (int a = 0; a < 2; ++a)
#pragma unroll
            for (int b = 0; b < 2; ++b)
#pragma unroll
                for (int m = 0; m < 4; ++m)
#pragma unroll
                    for (int n = 0; n < 2; ++n) acc[a][b][m][n] = (f32x4){0.f, 0.f, 0.f, 0.f};
        cur = nxt; cA = nA; cB = nB; ++ui;
        if constexpr (ALIGN_EPI) { if (wr == 1) PG8_BAR; }
    }
    PG8_WAIT_V(0);
    if constexpr (!ALIGN_EPI) { if (wr == 0) PG8_BAR; }
    PG8_BAR;
    if constexpr (Epi::AFTER_DRAIN) { E.fused(acc, cur, wr, wc, fr, fq, lds, wid, lane); S.done(cur); }
#undef PG8_SA
#undef PG8_SB
#undef PG8_STAGE
#undef PG8_LDA
#undef PG8_LDB
#undef PG8_MMA
#undef PG8_WAIT_V
#undef PG8_WAIT_L
#undef PG8_BAR
#undef PG8_SCHED
}
}

#define DEVI __device__ __forceinline__
typedef unsigned short bf16;
typedef short bf16x8 __attribute__((ext_vector_type(8)));
typedef short s16x4 __attribute__((ext_vector_type(4)));
typedef float f32x16 __attribute__((ext_vector_type(16)));
typedef float f32x4 __attribute__((ext_vector_type(4)));
typedef float f32x2 __attribute__((ext_vector_type(2)));
typedef unsigned u32x4 __attribute__((ext_vector_type(4)));
typedef unsigned u32x2 __attribute__((ext_vector_type(2)));

constexpr int SEQ = 8192, NB = 2, T = NB * SEQ, D = 1024, NIN = 2624, NINP = 2816, DFF = 2816, NUP = 5632;
constexpr float DN_ALPHA = 1.189207115002721f;
constexpr float QSCALE = 0.07216878364870323f * 1.4426950408889634f;
constexpr float RK_SCALE = 0.08838834764831845f;
constexpr size_t MiB = 1u << 20;
constexpr size_t WS_SSQ = 0, WS_MOD = 256 * 1024, WS_ZERO_BYTES = 512 * 1024;
constexpr size_t WS_CS = 1 * MiB;
constexpr size_t WS_WIN = 5 * MiB, WS_WUQ = 11 * MiB, WS_WUKV = 11 * MiB + 512 * 1024, WS_WOUT = 12 * MiB, WS_WUP = 14 * MiB, WS_WDOWN = 25 * MiB;
constexpr size_t WS_H1 = 32 * MiB, WS_YCAT = 32 * MiB;
constexpr size_t WS_RQ = 64 * MiB, WS_RK = 80 * MiB, WS_RV = 96 * MiB, WS_RG = 112 * MiB, WS_V1 = 64 * MiB;
constexpr size_t WS_CQ = 128 * MiB, WS_CKV = 136 * MiB, WS_QB = 144 * MiB, WS_KF = 168 * MiB, WS_VB = 192 * MiB, WS_KVT = 208 * MiB, WS_PREVT = 240 * MiB;
constexpr size_t WS_H2 = 130 * MiB, WS_ACT = 162 * MiB;
constexpr int LDS_BYTES = 147456;
constexpr int NPHASE = 11;

struct Args {
    const float* in[19]; float* out; unsigned char* ws;
    double inv_freq[64];
    float log2g[4];
    int ph_lo, ph_hi;
};

DEVI unsigned f2bf(float f) { unsigned u = __builtin_bit_cast(unsigned, f); return (u + 0x7fffu + ((u >> 16) & 1u)) >> 16; }
DEVI unsigned pk2(float lo, float hi) { return pg8::cvt_pk_bf16(lo, hi); }
DEVI float bf2f(unsigned short b) { return __builtin_bit_cast(float, ((unsigned)b) << 16); }
DEVI float bflo(unsigned w) { return __builtin_bit_cast(float, w << 16); }
DEVI float bfhi(unsigned w) { return __builtin_bit_cast(float, w & 0xffff0000u); }
DEVI float wave_sum(float v) {
#pragma unroll
    for (int o = 1; o < 64; o <<= 1) v += __shfl_xor(v, o);
    return v;
}
DEVI float siluf(float x) { return x * __builtin_amdgcn_rcpf(1.0f + __builtin_amdgcn_exp2f(-x * 1.4426950408889634f)); }
DEVI unsigned lds_addr(const void* p) { return (unsigned)(uintptr_t)p; }

enum { WK_IN = 0, WK_UQ = 1, WK_UKV = 2, WK_OUT = 3, WK_UP = 4, WK_DOWN = 5 };
DEVI int wsrc(int kind, int np) {
    if (kind == WK_IN) {
        if (np < 1024) { const int seg = np & ~511, h = (np >> 7) & 3, j = np & 127; return seg + h * 128 + (j >> 1) + 64 * (j & 1); }
        if (np < 2560) return np;
        if (np < 2624) { const int j = np - 2560; return 2560 + (j >> 1) + 32 * (j & 1); }
        return -1;
    }
    if (kind == WK_UQ) { const int h = np / 192, j = np - h * 192; if (j < 128) return np; const int jj = j - 128; return h * 192 + 128 + (jj >> 1) + 32 * (jj & 1); }
    if (kind == WK_UP) { const int pn = np >> 8, bj = (np >> 7) & 1, j = np & 127; return bj * DFF + 128 * pn + j; }
    return np;
}
DEVI void p0_transpose_item(int kind, const float* W, int K, int N, int NP, bf16* WT, const float* kscale, float* scr, int item, int lane) {
    const int nblk = NP / 32, kb = item / nblk, nb = item % nblk, k0 = 64 * kb, n0 = 32 * nb;
    const int np = n0 + (lane & 31), src = wsrc(kind, np);
    const float cs = (kind == WK_IN && np >= 512 && np < 1024) ? RK_SCALE : (kind == WK_UQ ? QSCALE : 1.0f);
#pragma unroll 8
    for (int i = 0; i < 32; ++i) { const int kk = 2 * i + (lane >> 5);
        float v = src >= 0 ? W[(size_t)(k0 + kk) * N + src] * cs : 0.f;
        if (kscale) v *= kscale[k0 + kk];
        scr[kk * 33 + (lane & 31)] = v; }
    asm volatile("s_waitcnt lgkmcnt(0)" ::: "memory");
    const int c = lane & 7;
#pragma unroll
    for (int j = 0; j < 4; ++j) { const int n = (lane >> 3) + 8 * j; const float* s = scr + (8 * c) * 33 + n;
        u32x4 o; o.x = pk2(s[0 * 33], s[1 * 33]); o.y = pk2(s[2 * 33], s[3 * 33]); o.z = pk2(s[4 * 33], s[5 * 33]); o.w = pk2(s[6 * 33], s[7 * 33]);
        *(u32x4*)(WT + (size_t)(n0 + n) * K + k0 + 8 * c) = o; }
    asm volatile("s_waitcnt lgkmcnt(0)" ::: "memory");
}

using pg8::Unit;
typedef const f32x4 (&AccRef)[2][2][4][2];

DEVI void rope4(f32x4& v0, f32x4& v1, const f32x2* cs, int stride) {
    const f32x2 c0 = cs[0], c1 = cs[stride], c2 = cs[2 * stride], c3 = cs[3 * stride];
    f32x4 a = v0, b = v1;
    v0[0] = a[0] * c0.x - a[1] * c0.y; v0[1] = a[1] * c0.x + a[0] * c0.y;
    v0[2] = a[2] * c1.x - a[3] * c1.y; v0[3] = a[3] * c1.x + a[2] * c1.y;
    v1[0] = b[0] * c2.x - b[1] * c2.y; v1[1] = b[1] * c2.x + b[0] * c2.y;
    v1[2] = b[2] * c3.x - b[3] * c3.y; v1[3] = b[3] * c3.x + b[2] * c3.y;
}
DEVI u32x4 pack8(const f32x4& v0, const f32x4& v1) { u32x4 w; w.x = pk2(v0[0], v0[1]); w.y = pk2(v0[2], v0[3]); w.z = pk2(v1[0], v1[1]); w.w = pk2(v1[2], v1[3]); return w; }

struct EpiInProj {
    static constexpr bool PERM = true, AFTER_DRAIN = false;
    bf16 *RQ, *RK, *RV, *RG, *CQ, *CKV, *KF; float* SSQ; const f32x2* CS;
    DEVI void operator()(AccRef acc, const Unit& u, int wr, int wc, int fr, int fq) const {
        const int pn = u.pn, row0 = u.pm * 256 + wr * 64 + fr, cl = wc * 32 + 8 * fq;
#pragma unroll
        for (int ai = 0; ai < 2; ++ai)
#pragma unroll
            for (int m = 0; m < 4; ++m) {
                const int row = row0 + ai * 128 + m * 16, pos = row & (SEQ - 1);
                float ss = 0.f;
#pragma unroll
                for (int bj = 0; bj < 2; ++bj) {
                    f32x4 v0 = acc[ai][bj][m][0], v1 = acc[ai][bj][m][1];
                    const int c = pn * 256 + bj * 128 + cl;
                    if (pn < 4) {
                        const int cc = c & 511;
                        rope4(v0, v1, CS + (size_t)pos * 64 + ((cc & 127) >> 1), 1);
                        *(u32x4*)((pn < 2 ? RQ : RK) + (size_t)row * 512 + cc) = pack8(v0, v1);
                    } else if (pn < 8) {
                        *(u32x4*)((pn < 6 ? RV : RG) + (size_t)row * 512 + (c & 511)) = pack8(v0, v1);
                    } else if (pn < 10) {
                        *(u32x4*)((pn == 8 ? CQ : CKV) + (size_t)row * 256 + (c & 255)) = pack8(v0, v1);
                        ss += (v0[0] * v0[0] + v0[1] * v0[1]) + (v0[2] * v0[2] + v0[3] * v0[3]) + (v1[0] * v1[0] + v1[1] * v1[1]) + (v1[2] * v1[2] + v1[3] * v1[3]);
                    } else if (c < NIN) {
                        const int j = c - 2560;
                        rope4(v0, v1, CS + (size_t)pos * 64 + j, 2);
                        const u32x4 w = pack8(v0, v1);
#pragma unroll
                        for (int h = 0; h < 4; ++h) *(u32x4*)(KF + (size_t)row * 768 + h * 192 + 128 + j) = w;
                    }
                }
                if (pn == 8 || pn == 9) { ss += __shfl_xor(ss, 16); ss += __shfl_xor(ss, 32); if (fq == 0) atomicAdd(SSQ + (size_t)row * 2 + (pn - 8), ss); }
                asm volatile("" ::: "memory");
            }
    }
};
struct EpiMlaQ {
    static constexpr bool PERM = true, AFTER_DRAIN = false;
    bf16* QB; const float* SSQ; const f32x2* CS;
    DEVI void operator()(AccRef acc, const Unit& u, int wr, int wc, int fr, int fq) const {
        const int row0 = u.pm * 256 + wr * 64 + fr, cl = wc * 32 + 8 * fq;
#pragma unroll
        for (int ai = 0; ai < 2; ++ai)
#pragma unroll
            for (int m = 0; m < 4; ++m) {
                const int row = row0 + ai * 128 + m * 16, pos = row & (SEQ - 1);
                const float rstd = 1.0f / sqrtf(SSQ[(size_t)row * 2] * (1.0f / 256.0f) + 1e-6f);
#pragma unroll
                for (int bj = 0; bj < 2; ++bj) {
                    f32x4 v0 = acc[ai][bj][m][0] * rstd, v1 = acc[ai][bj][m][1] * rstd;
                    const int c = u.pn * 256 + bj * 128 + cl, h = c / 192, j = c - h * 192;
                    if (j >= 128) rope4(v0, v1, CS + (size_t)pos * 64 + (j - 128), 2);
                    *(u32x4*)(QB + (size_t)row * 768 + c) = pack8(v0, v1);
                }
                asm volatile("" ::: "memory");
            }
    }
};
struct EpiMlaKV {
    static constexpr bool PERM = true, AFTER_DRAIN = false;
    bf16 *KF, *VB; const float* SSQ;
    DEVI void operator()(AccRef acc, const Unit& u, int wr, int wc, int fr, int fq) const {
        const int row0 = u.pm * 256 + wr * 64 + fr, cl = wc * 32 + 8 * fq, h = u.pn;
#pragma unroll
        for (int ai = 0; ai < 2; ++ai)
#pragma unroll
            for (int m = 0; m < 4; ++m) {
                const int row = row0 + ai * 128 + m * 16;
                const float rstd = 1.0f / sqrtf(SSQ[(size_t)row * 2 + 1] * (1.0f / 256.0f) + 1e-6f);
                { f32x4 v0 = acc[ai][0][m][0] * rstd, v1 = acc[ai][0][m][1] * rstd; *(u32x4*)(KF + (size_t)row * 768 + h * 192 + cl) = pack8(v0, v1); }
                { f32x4 v0 = acc[ai][1][m][0] * rstd, v1 = acc[ai][1][m][1] * rstd; *(u32x4*)(VB + (size_t)row * 512 + h * 128 + cl) = pack8(v0, v1); }
                asm volatile("" ::: "memory");
            }
    }
};
struct EpiResid {
    static constexpr bool PERM = false, AFTER_DRAIN = false;
    const float* res; float* dst; const float* gate;
    DEVI void operator()(AccRef acc, const Unit& u, int wr, int wc, int fr, int fq) const {
        const int row0 = u.pm * 256 + wr * 64 + fr, col0 = u.pn * 256 + wc * 32 + 4 * fq;
#pragma unroll
        for (int ai = 0; ai < 2; ++ai)
#pragma unroll
            for (int m = 0; m < 4; ++m) {
                const int row = row0 + ai * 128 + m * 16; const float* g = gate + (row >> 13) * (6 * D);
#pragma unroll
                for (int bj = 0; bj < 2; ++bj)
#pragma unroll
                    for (int n = 0; n < 2; ++n) {
                        const int c = col0 + bj * 128 + n * 16; const size_t off = (size_t)row * D + c;
                        const f32x4 r = *(const f32x4*)(res + off), gg = *(const f32x4*)(g + c);
                        *(f32x4*)(dst + off) = r * DN_ALPHA + (gg + 1.0f) * acc[ai][bj][m][n];
                    }
                asm volatile("" ::: "memory");
            }
    }
};
DEVI float dpp_shr1_f(float x) { float r; asm volatile("s_nop 1\n\tv_mov_b32_dpp %0, %1 row_shr:1 row_mask:0xf bank_mask:0xf bound_ctrl:1" : "=v"(r) : "v"(x)); return r; }
DEVI f32x4 dpp_shr1(const f32x4& v) { f32x4 r; r[0] = dpp_shr1_f(v[0]); r[1] = dpp_shr1_f(v[1]); r[2] = dpp_shr1_f(v[2]); r[3] = dpp_shr1_f(v[3]); return r; }
struct EpiUpConv {
    static constexpr bool PERM = true, AFTER_DRAIN = false;
    bf16* ACT; const float* cw; const float* cb;
    DEVI void operator()(AccRef acc, const Unit& u, int wr, int wc, int fr, int fq) const {
        const int tok0 = u.pm * 252 - 2 + wr * 126 + fr * 8, colg = u.pn * 128 + wc * 32 + 8 * fq;
#pragma unroll
        for (int n = 0; n < 2; ++n) {
            const int cg4 = colg + 4 * n;
            const f32x4 w0g = *(const f32x4*)(cw + cg4), w1g = *(const f32x4*)(cw + NUP + cg4), w2g = *(const f32x4*)(cw + 2 * NUP + cg4), bg = *(const f32x4*)(cb + cg4);
            const f32x4 w0v = *(const f32x4*)(cw + DFF + cg4), w1v = *(const f32x4*)(cw + NUP + DFF + cg4), w2v = *(const f32x4*)(cw + 2 * NUP + DFF + cg4), bv = *(const f32x4*)(cb + DFF + cg4);
            f32x4 g1 = dpp_shr1(acc[1][0][3][n]), g2 = dpp_shr1(acc[1][0][2][n]);
            f32x4 v1 = dpp_shr1(acc[1][1][3][n]), v2 = dpp_shr1(acc[1][1][2][n]);
#pragma unroll
            for (int k = 0; k < 8; ++k) {
                const f32x4 ug = acc[k >> 2][0][k & 3][n], uv = acc[k >> 2][1][k & 3][n];
                const int t = tok0 + k, pos = t & (SEQ - 1);
                f32x4 a1 = g1, a2 = g2, b1 = v1, b2 = v2;
                if (pos < 1) { a1 = (f32x4){0.f, 0.f, 0.f, 0.f}; b1 = a1; }
                if (pos < 2) { a2 = (f32x4){0.f, 0.f, 0.f, 0.f}; b2 = a2; }
                const f32x4 cgv = bg + w2g * ug + w1g * a1 + w0g * a2, cvv = bv + w2v * uv + w1v * b1 + w0v * b2;
                g2 = g1; g1 = ug; v2 = v1; v1 = uv;
                if (t < T && !(fr == 0 && k < 2)) {
                    u32x2 w; w.x = pk2(siluf(cgv[0]) * cvv[0], siluf(cgv[1]) * cvv[1]); w.y = pk2(siluf(cgv[2]) * cvv[2], siluf(cgv[3]) * cvv[3]);
                    *(u32x2*)(ACT + (size_t)t * DFF + cg4) = w;
                }
            }
        }
    }
};

namespace att {
constexpr int KT = 64 * 192 * 2, VT = 64 * 128 * 2, BUF = KT + VT;
DEVI int v_st(int k, int c) { const int kk = (k & ~0xC) | ((k & 4) << 1) | ((k & 8) >> 1); return ((kk >> 3) * 4 + (c >> 5)) * 512 + ((kk & 7) * 32 + (c & 31)) * 2; }
DEVI int v_rd_base(int lane) { return ((lane & 3) << 3) | (((lane >> 2) & 3) << 6) | (((lane >> 4) & 1) << 5) | (((lane >> 5) & 1) << 8); }
constexpr int v_rd_off(int d0, int ks, int half) { return d0 * 512 + ks * 4096 + half * 2048; }
DEVI int crow(int r, int hi) { return (r & 3) + 8 * (r >> 2) + 4 * hi; }
#define ATT_PK4(P, B_, OUT) do { unsigned a0 = pk2(P[B_+0], P[B_+1]), a1 = pk2(P[B_+2], P[B_+3]);                          \
        unsigned b0 = pk2(P[B_+4], P[B_+5]), b1 = pk2(P[B_+6], P[B_+7]);                                             \
        auto r0 = __builtin_amdgcn_permlane32_swap(a0, b0, false, false); auto r1 = __builtin_amdgcn_permlane32_swap(a1, b1, false, false); \
        u32x4 w = {r0[0], r1[0], r0[1], r1[1]}; OUT = __builtin_bit_cast(bf16x8, w); } while (0)
#define ATT_TRRD(dst, base, off) asm volatile("ds_read_b64_tr_b16 %0, %1 offset:%2" : "=&v"(dst) : "v"(base), "i"(off) : "memory")
#define ATT_MK8(l, h) ((bf16x8){l[0], l[1], l[2], l[3], h[0], h[1], h[2], h[3]})
DEVI float swapmax(float v) { auto rr = __builtin_amdgcn_permlane32_swap(__float_as_uint(v), __float_as_uint(v), false, false); return fmaxf(__uint_as_float(rr[0]), __uint_as_float(rr[1])); }
DEVI float swapsum(float v) { auto rr = __builtin_amdgcn_permlane32_swap(__float_as_uint(v), __float_as_uint(v), false, false); return __uint_as_float(rr[0]) + __uint_as_float(rr[1]); }

DEVI void attn_block(char* lds, const bf16* QB, const bf16* KF, const bf16* VB, bf16* Y, int b, int h, int qb) {
    const int tid = threadIdx.x, wid = __builtin_amdgcn_readfirstlane(tid >> 6), lane = tid & 63, r32 = lane & 31, hi = lane >> 5, qg = wid & 3, kh = wid >> 2;
    const int q0 = qb * 128, NT = 2 * (qb + 1);
    const size_t tokb = (size_t)b * SEQ;
    bf16x8 qr[12];
    { const bf16* qp = QB + (tokb + q0 + qg * 32 + r32) * 768 + h * 192 + hi * 8;
#pragma unroll
      for (int d0 = 0; d0 < 12; ++d0) qr[d0] = *(const bf16x8*)(qp + d0 * 16); }
    int kgo[3], klo[3];
#pragma unroll
    for (int i = 0; i < 3; ++i) { const int q = tid + 512 * i, row = q / 24, ch = q - row * 24; kgo[i] = row * 768 + ch * 8; klo[i] = row * 384 + ((ch ^ (row & 7)) << 4); }
    const int sr = tid >> 4, sc = (tid & 15) * 8;
    const int vgo0 = sr * 512 + sc, vgo1 = (32 + sr) * 512 + sc, vlo0 = KT + v_st(sr, sc), vlo1 = KT + v_st(32 + sr, sc);
    const bf16* Kg = KF + tokb * 768 + h * 192; const bf16* Vg = VB + tokb * 512 + h * 128;
    bf16x8 sk0, sk1, sk2, sv0, sv1;
#define ATT_LOADT(t) do { const bf16* kp_ = Kg + (size_t)(t) * (64 * 768); const bf16* vp_ = Vg + (size_t)(t) * (64 * 512); \
        sk0 = *(const bf16x8*)(kp_ + kgo[0]); sk1 = *(const bf16x8*)(kp_ + kgo[1]); sk2 = *(const bf16x8*)(kp_ + kgo[2]); sv0 = *(const bf16x8*)(vp_ + vgo0); sv1 = *(const bf16x8*)(vp_ + vgo1); } while (0)
#define ATT_WRITET(bf) do { char* b_ = lds + (bf) * BUF; *(bf16x8*)(b_ + klo[0]) = sk0; *(bf16x8*)(b_ + klo[1]) = sk1; *(bf16x8*)(b_ + klo[2]) = sk2; *(bf16x8*)(b_ + vlo0) = sv0; *(bf16x8*)(b_ + vlo1) = sv1; } while (0)
    ATT_LOADT(0); ATT_WRITET(0); __syncthreads();
    float m_reg = -1e30f, l_reg = 0.f; f32x16 o[4];
#pragma unroll
    for (int d0 = 0; d0 < 4; ++d0) o[d0] = (f32x16){};
    const int ksw = r32 & 7, kro = (kh * 32 + r32) * 384;
    int kx[4];
#pragma unroll
    for (int bq = 0; bq < 4; ++bq) kx[bq] = kro + (((2 * bq + hi) ^ ksw) << 4);
    const unsigned vb_base = lds_addr(lds) + KT + v_rd_base(lane) + kh * 8192;
    const int qabs = q0 + qg * 32 + r32;
    for (int t = 0; t < NT; ++t) {
        const int cur = t & 1;
        if (t + 1 < NT) ATT_LOADT(t + 1);
        f32x16 p = (f32x16){};
        { const char* kb = lds + cur * BUF;
#pragma unroll
          for (int d0 = 0; d0 < 12; ++d0) { const bf16x8 kf = *(const bf16x8*)(kb + kx[d0 & 3] + (d0 >> 2) * 128); p = __builtin_amdgcn_mfma_f32_32x32x16_bf16(kf, qr[d0], p, 0, 0, 0); } }
        if (t >= NT - 2) { const int dq = qabs - (t * 64 + kh * 32) - 4 * hi; const float NEG = -__builtin_inff();
#pragma unroll
            for (int r = 0; r < 16; ++r) { const int c = (r & 3) + 8 * (r >> 2); if (c > dq) p[r] = NEG; } }
        float pmax = p[0];
#pragma unroll
        for (int r = 1; r < 16; ++r) pmax = fmaxf(pmax, p[r]);
        pmax = swapmax(pmax);
        float alpha, mn;
        if (__builtin_expect(__all(pmax - m_reg <= 8.0f), 1)) { mn = m_reg; alpha = 1.f; }
        else { mn = fmaxf(m_reg, pmax); alpha = __builtin_amdgcn_exp2f(m_reg - mn); m_reg = mn; }
#pragma unroll
        for (int r = 0; r < 16; ++r) p[r] = __builtin_amdgcn_exp2f(p[r] - mn);
        float ps = 0.f;
#pragma unroll
        for (int r = 0; r < 16; ++r) ps += p[r];
        ps = swapsum(ps);
        l_reg = l_reg * alpha + ps;
        bf16x8 pa0, pa1; ATT_PK4(p, 0, pa0); ATT_PK4(p, 8, pa1);
        if (__any(alpha < 1.f)) {
#pragma unroll
            for (int d0 = 0; d0 < 4; ++d0) o[d0] = o[d0] * alpha; }
        { const unsigned vb = vb_base + cur * BUF;
#pragma unroll
          for (int d0 = 0; d0 < 4; ++d0) { s16x4 l0, h0, l1, h1;
            ATT_TRRD(l0, vb, d0 * 512); ATT_TRRD(h0, vb, d0 * 512 + 2048); ATT_TRRD(l1, vb, d0 * 512 + 4096); ATT_TRRD(h1, vb, d0 * 512 + 6144);
            asm volatile("s_waitcnt lgkmcnt(0)" ::: "memory"); __builtin_amdgcn_sched_barrier(0);
            o[d0] = __builtin_amdgcn_mfma_f32_32x32x16_bf16(ATT_MK8(l0, h0), pa0, o[d0], 0, 0, 0);
            o[d0] = __builtin_amdgcn_mfma_f32_32x32x16_bf16(ATT_MK8(l1, h1), pa1, o[d0], 0, 0, 0); } }
        if (t + 1 < NT) ATT_WRITET(cur ^ 1);
        __syncthreads();
    }
    float* cmb = (float*)lds + qg * (66 * 64) + lane;
    if (kh == 1) {
#pragma unroll
        for (int d0 = 0; d0 < 4; ++d0)
#pragma unroll
            for (int r = 0; r < 16; ++r) cmb[(d0 * 16 + r) * 64] = o[d0][r];
        cmb[64 * 64] = m_reg; cmb[65 * 64] = l_reg;
    }
    __syncthreads();
    if (kh == 0) {
        const float m1 = cmb[64 * 64], l1 = cmb[65 * 64], mn = fmaxf(m_reg, m1), a0 = __builtin_amdgcn_exp2f(m_reg - mn), a1 = __builtin_amdgcn_exp2f(m1 - mn);
        const float inv = 1.0f / (l_reg * a0 + l1 * a1), s0 = a0 * inv, s1 = a1 * inv;
        bf16* yp = Y + (tokb + q0 + qg * 32 + r32) * 1024 + 512 + h * 128 + 4 * hi;
#pragma unroll
        for (int d0 = 0; d0 < 4; ++d0)
#pragma unroll
            for (int g = 0; g < 4; ++g) { float v[4];
#pragma unroll
                for (int j = 0; j < 4; ++j) v[j] = o[d0][4 * g + j] * s0 + cmb[(d0 * 16 + 4 * g + j) * 64] * s1;
                u32x2 w; w.x = pk2(v[0], v[1]); w.y = pk2(v[2], v[3]);
#ifdef DBG_ZERO_MLA
                w.x = 0; w.y = 0;
#endif
                *(u32x2*)(yp + d0 * 32 + 8 * g) = w; }
    }
    __syncthreads();
#undef ATT_LOADT
#undef ATT_WRITET
}

DEVI void stage_chunk(char* dst, const bf16* src, int t2, float scale_l2g) {
#pragma unroll
    for (int i = 0; i < 8; ++i) { const int s = t2 + 256 * i, k = s >> 4, c = (s & 15) * 8;
        u32x4 w = *(const u32x4*)(src + (size_t)k * 512 + c);
        if (scale_l2g != 0.f) { const float f = __builtin_amdgcn_exp2f((float)(127 - k) * scale_l2g);
            w.x = pk2(bflo(w.x) * f, bfhi(w.x) * f); w.y = pk2(bflo(w.y) * f, bfhi(w.y) * f); w.z = pk2(bflo(w.z) * f, bfhi(w.z) * f); w.w = pk2(bflo(w.w) * f, bfhi(w.w) * f); }
        *(u32x4*)(dst + (k >> 6) * 16384 + v_st(k & 63, c)) = w; }
}
DEVI void ret_chunk_kv(char* lds, const bf16* RK, const bf16* RV, float* KVT, int bh, int cp, float l2g) {
    const int tid = threadIdx.x, wid = __builtin_amdgcn_readfirstlane(tid >> 6), lane = tid & 63, r32 = lane & 31, hi = lane >> 5, half = wid >> 2, et = wid & 3;
    const int b = bh >> 2, h = bh & 3, c = 2 * cp + half;
    const size_t tok0 = (size_t)b * SEQ + c * 128;
    char* Vs = lds + half * 65536; char* Ks = Vs + 32768;
    stage_chunk(Vs, RV + tok0 * 512 + h * 128, tid & 255, 0.f);
    stage_chunk(Ks, RK + tok0 * 512 + h * 128, tid & 255, l2g);
    __syncthreads();
    f32x16 acc[4];
#pragma unroll
    for (int dt = 0; dt < 4; ++dt) acc[dt] = (f32x16){};
    const unsigned vb = lds_addr(Vs) + v_rd_base(lane) + et * 512, kb = lds_addr(Ks) + v_rd_base(lane);
#pragma unroll
    for (int ks = 0; ks < 8; ++ks) {
        s16x4 vl, vh, kl[4], khh[4];
        ATT_TRRD(vl, vb, ks * 4096); ATT_TRRD(vh, vb, ks * 4096 + 2048);
#pragma unroll
        for (int dt = 0; dt < 4; ++dt) { ATT_TRRD(kl[dt], kb, dt * 512 + ks * 4096); ATT_TRRD(khh[dt], kb, dt * 512 + ks * 4096 + 2048); }
        asm volatile("s_waitcnt lgkmcnt(0)" ::: "memory"); __builtin_amdgcn_sched_barrier(0);
        const bf16x8 vf = ATT_MK8(vl, vh);
#pragma unroll
        for (int dt = 0; dt < 4; ++dt) acc[dt] = __builtin_amdgcn_mfma_f32_32x32x16_bf16(vf, ATT_MK8(kl[dt], khh[dt]), acc[dt], 0, 0, 0);
    }
    float* out = KVT + ((size_t)(bh * 64 + c) * 128 + et * 32) * 128 + r32;
#pragma unroll
    for (int dt = 0; dt < 4; ++dt)
#pragma unroll
        for (int r = 0; r < 16; ++r) out[(size_t)crow(r, hi) * 128 + dt * 32] = acc[dt][r];
    __syncthreads();
}
DEVI void ret_out(char* lds, const bf16* RQ, const bf16* RK, const bf16* RV, const bf16* RG, const bf16* PREVT, const float* gnw, bf16* Y, int bh, int cp, float l2g) {
    const int tid = threadIdx.x, wid = __builtin_amdgcn_readfirstlane(tid >> 6), lane = tid & 63, r32 = lane & 31, hi = lane >> 5, half = wid >> 2, nb = wid & 3;
    const int b = bh >> 2, h = bh & 3, c = 2 * cp + half;
    const size_t tok0 = (size_t)b * SEQ + c * 128;
    char* Vs = lds + half * 32768;
    stage_chunk(Vs, RV + tok0 * 512 + h * 128, tid & 255, 0.f);
    bf16x8 qf[8];
    { const bf16* qp = RQ + (tok0 + nb * 32 + r32) * 512 + h * 128 + hi * 8;
#pragma unroll
      for (int d0 = 0; d0 < 8; ++d0) qf[d0] = *(const bf16x8*)(qp + d0 * 16); }
    f32x16 o[4];
#pragma unroll
    for (int et = 0; et < 4; ++et) o[et] = (f32x16){};
    { const bf16* pp = PREVT + (size_t)(bh * 64 + c) * 16384 + (size_t)r32 * 128 + hi * 8;
#pragma unroll
      for (int et = 0; et < 4; ++et)
#pragma unroll
        for (int d0 = 0; d0 < 8; ++d0) { const bf16x8 pf = *(const bf16x8*)(pp + et * 32 * 128 + d0 * 16); o[et] = __builtin_amdgcn_mfma_f32_32x32x16_bf16(pf, qf[d0], o[et], 0, 0, 0); } }
    const int nl = nb * 32 + r32;
    { const float qw = __builtin_amdgcn_exp2f((float)(nl + 1) * l2g);
#pragma unroll
      for (int et = 0; et < 4; ++et) o[et] = o[et] * qw; }
    __syncthreads();
    const unsigned vb = lds_addr(Vs) + v_rd_base(lane);
#pragma unroll
    for (int mt = 0; mt < 4; ++mt) {
        if (mt <= nb) {
            f32x16 p = (f32x16){};
            const bf16* kp = RK + (tok0 + mt * 32 + r32) * 512 + h * 128 + hi * 8;
#pragma unroll
            for (int d0 = 0; d0 < 8; ++d0) { const bf16x8 kf = *(const bf16x8*)(kp + d0 * 16); p = __builtin_amdgcn_mfma_f32_32x32x16_bf16(kf, qf[d0], p, 0, 0, 0); }
#pragma unroll
            for (int r = 0; r < 16; ++r) { const int dl = nl - (mt * 32 + crow(r, hi)); p[r] = dl >= 0 ? p[r] * __builtin_amdgcn_exp2f((float)dl * l2g) : 0.f; }
            bf16x8 pa0, pa1; ATT_PK4(p, 0, pa0); ATT_PK4(p, 8, pa1);
#pragma unroll
            for (int et = 0; et < 4; ++et) { s16x4 l0, h0, l1, h1;
                ATT_TRRD(l0, vb, et * 512 + (2 * mt) * 4096); ATT_TRRD(h0, vb, et * 512 + (2 * mt) * 4096 + 2048);
                ATT_TRRD(l1, vb, et * 512 + (2 * mt + 1) * 4096); ATT_TRRD(h1, vb, et * 512 + (2 * mt + 1) * 4096 + 2048);
                asm volatile("s_waitcnt lgkmcnt(0)" ::: "memory"); __builtin_amdgcn_sched_barrier(0);
                o[et] = __builtin_amdgcn_mfma_f32_32x32x16_bf16(ATT_MK8(l0, h0), pa0, o[et], 0, 0, 0);
                o[et] = __builtin_amdgcn_mfma_f32_32x32x16_bf16(ATT_MK8(l1, h1), pa1, o[et], 0, 0, 0); }
        }
    }
    float s = 0.f;
#pragma unroll
    for (int et = 0; et < 4; ++et)
#pragma unroll
        for (int r = 0; r < 16; ++r) s += o[et][r];
    const float mean = swapsum(s) * (1.0f / 128.0f);
    float q = 0.f;
#pragma unroll
    for (int et = 0; et < 4; ++et)
#pragma unroll
        for (int r = 0; r < 16; ++r) { const float d = o[et][r] - mean; q += d * d; }
    const float rstd = 1.0f / sqrtf(swapsum(q) * (1.0f / 128.0f) + 1e-5f);
    const size_t tok = tok0 + nl;
    const bf16* gp = RG + tok * 512 + h * 128 + 4 * hi; const float* wp = gnw + h * 128 + 4 * hi; bf16* yp = Y + tok * 1024 + h * 128 + 4 * hi;
#pragma unroll
    for (int et = 0; et < 4; ++et)
#pragma unroll
        for (int g = 0; g < 4; ++g) { const int e = et * 32 + 8 * g;
            const u32x2 gw = *(const u32x2*)(gp + e); const f32x4 ww = *(const f32x4*)(wp + e);
            const float g0 = siluf(bflo(gw.x)), g1 = siluf(bfhi(gw.x)), g2 = siluf(bflo(gw.y)), g3 = siluf(bfhi(gw.y));
            u32x2 w; w.x = pk2((o[et][4 * g] - mean) * rstd * ww[0] * g0, (o[et][4 * g + 1] - mean) * rstd * ww[1] * g1);
            w.y = pk2((o[et][4 * g + 2] - mean) * rstd * ww[2] * g2, (o[et][4 * g + 3] - mean) * rstd * ww[3] * g3);
            *(u32x2*)(yp + e) = w; }
    __syncthreads();
}
}

__global__ void __launch_bounds__(512, 2) fwd_kernel(Args args) {
    extern __shared__ __attribute__((aligned(16))) char lds[];
    cg::grid_group grid = cg::this_grid();
    const int tid = threadIdx.x, lane = tid & 63, wave = __builtin_amdgcn_readfirstlane(tid >> 6);
    const int G = gridDim.x, bx = blockIdx.x;
    const int gw = bx * 8 + wave, NGW = G * 8;
    unsigned char* ws = args.ws;
    const float* x = args.in[0]; const float* cvec = args.in[1]; const float* w_ada = args.in[2]; const float* b_ada = args.in[3];
    const float* w_in = args.in[4]; const float* ret_gn_w = args.in[5]; const float* q_norm_w = args.in[6]; const float* w_uq = args.in[7];
    const float* kv_norm_w = args.in[8]; const float* w_ukv = args.in[9]; const float* w_out = args.in[10]; const float* ln1_w = args.in[11]; const float* ln1_b = args.in[12];
    const float* w_up = args.in[13]; const float* conv_w = args.in[14]; const float* conv_b = args.in[15]; const float* w_down = args.in[16]; const float* ln2_w = args.in[17]; const float* ln2_b = args.in[18];
    float* SSQ = (float*)(ws + WS_SSQ); float* MOD = (float*)(ws + WS_MOD); f32x2* CS = (f32x2*)(ws + WS_CS);
    bf16* WIN = (bf16*)(ws + WS_WIN); bf16* WUQ = (bf16*)(ws + WS_WUQ); bf16* WUKV = (bf16*)(ws + WS_WUKV); bf16* WOUT = (bf16*)(ws + WS_WOUT); bf16* WUP = (bf16*)(ws + WS_WUP); bf16* WDOWN = (bf16*)(ws + WS_WDOWN);
    bf16* H1 = (bf16*)(ws + WS_H1); bf16* YCAT = (bf16*)(ws + WS_YCAT);
    bf16* RQ = (bf16*)(ws + WS_RQ); bf16* RK = (bf16*)(ws + WS_RK); bf16* RV = (bf16*)(ws + WS_RV); bf16* RG = (bf16*)(ws + WS_RG); float* V1 = (float*)(ws + WS_V1);
    bf16* CQ = (bf16*)(ws + WS_CQ); bf16* CKV = (bf16*)(ws + WS_CKV); bf16* QB = (bf16*)(ws + WS_QB); bf16* KF = (bf16*)(ws + WS_KF); bf16* VB = (bf16*)(ws + WS_VB);
    float* KVT = (float*)(ws + WS_KVT); bf16* PREVT = (bf16*)(ws + WS_PREVT); bf16* H2 = (bf16*)(ws + WS_H2); bf16* ACT = (bf16*)(ws + WS_ACT);
    float* out = args.out;
    PG8_LAS unsigned char* glds = (PG8_LAS unsigned char*)lds;
    const int lo = args.ph_lo, hi_ph = args.ph_hi;
#ifndef PHMASK
#define PHMASK 0x7ff
#endif
#define IN(k) (((PHMASK >> (k)) & 1) && lo <= (k) && (k) < hi_ph)
#define SEAM(k) do { if (IN(k) && IN((k) + 1)) grid.sync(); } while (0)

    if (IN(0)) {
        float* scr = (float*)lds + wave * 4096;
        constexpr int I_IN = 16 * (NINP / 32), I_UQ = 4 * 24, I_UKV = 4 * 32, I_OUT = 16 * 32, I_UP = 16 * (NUP / 32), I_DOWN = 44 * 32;
        constexpr int NT0 = I_IN + I_UQ + I_UKV + I_OUT + I_UP + I_DOWN;
        for (int it = gw; it < NT0; it += NGW) {
            int r = it;
            if (r < I_UP) { p0_transpose_item(WK_UP, w_up, D, NUP, NUP, WUP, nullptr, scr, r, lane); continue; } r -= I_UP;
            if (r < I_IN) { p0_transpose_item(WK_IN, w_in, D, NIN, NINP, WIN, nullptr, scr, r, lane); continue; } r -= I_IN;
            if (r < I_DOWN) { p0_transpose_item(WK_DOWN, w_down, DFF, D, D, WDOWN, nullptr, scr, r, lane); continue; } r -= I_DOWN;
            if (r < I_OUT) { p0_transpose_item(WK_OUT, w_out, D, D, D, WOUT, nullptr, scr, r, lane); continue; } r -= I_OUT;
            if (r < I_UKV) { p0_transpose_item(WK_UKV, w_ukv, 256, 1024, 1024, WUKV, kv_norm_w, scr, r, lane); continue; } r -= I_UKV;
            p0_transpose_item(WK_UQ, w_uq, 256, 768, 768, WUQ, q_norm_w, scr, r, lane);
        }
        for (int it = gw; it < 32 * 24; it += NGW) {
            const int ksl = it / 24, nt = it % 24, n = nt * 256 + lane * 4;
            f32x4 a0 = (f32x4){0.f, 0.f, 0.f, 0.f}, a1 = a0;
            if (ksl == 0) { a0 = *(const f32x4*)(b_ada + n); a1 = a0; }
#pragma unroll 8
            for (int kk = 0; kk < 32; ++kk) { const int k = ksl * 32 + kk; const f32x4 w = *(const f32x4*)(w_ada + (size_t)k * 6144 + n);
                a0 += w * siluf(cvec[k]); a1 += w * siluf(cvec[D + k]); }
#pragma unroll
            for (int j = 0; j < 4; ++j) { atomicAdd(MOD + n + j, a0[j]); atomicAdd(MOD + 6144 + n + j, a1[j]); }
        }
        for (int e = bx * 512 + tid; e < SEQ * 64; e += G * 512) { const int pos = e >> 6, i = e & 63;
            const double rev = (double)pos * args.inv_freq[i] * 0.15915494309189535; const float fr = (float)(rev - floor(rev));
            CS[e] = (f32x2){__builtin_amdgcn_cosf(fr), __builtin_amdgcn_sinf(fr)}; }
    }
    SEAM(0);
    if (IN(1)) {
        for (int row = gw; row < T; row += NGW) {
            const f32x4* xr = (const f32x4*)(x + (size_t)row * D) + lane; const float* md = MOD + (row >> 13) * 6144;
            f32x4 v[4]; float s = 0.f;
#pragma unroll
            for (int j = 0; j < 4; ++j) { v[j] = xr[64 * j]; s += (v[j][0] + v[j][1]) + (v[j][2] + v[j][3]); }
            const float mean = wave_sum(s) * (1.f / D); float s2 = 0.f;
#pragma unroll
            for (int j = 0; j < 4; ++j) { v[j] = v[j] - mean; s2 += (v[j][0] * v[j][0] + v[j][1] * v[j][1]) + (v[j][2] * v[j][2] + v[j][3] * v[j][3]); }
            const float rstd = 1.f / sqrtf(wave_sum(s2) * (1.f / D) + 1e-5f);
            u32x2* o8 = (u32x2*)(H1 + (size_t)row * D) + lane;
#pragma unroll
            for (int j = 0; j < 4; ++j) { const int c = 4 * lane + 256 * j; const f32x4 sh = *(const f32x4*)(md + c), sc = *(const f32x4*)(md + 1024 + c);
                const f32x4 y = v[j] * rstd * (sc + 1.0f) + sh; u32x2 w; w.x = pk2(y[0], y[1]); w.y = pk2(y[2], y[3]); o8[64 * j] = w; }
        }
    }
    SEAM(1);
    if (IN(2)) {
        pg8::Gemm g{H1, WIN, T, NINP, D}; pg8::StaticOrder S; S.init(T, NINP, G, bx);
        EpiInProj E{RQ, RK, RV, RG, CQ, CKV, KF, SSQ, CS};
        pg8::gemm_phase<EpiInProj, pg8::StaticOrder, true, true>(glds, g, S, E);
    }
    SEAM(2);
    if (IN(3)) {
#ifndef P3SKIP
#define P3SKIP 0
#endif
        if (!(P3SKIP & 1)) { pg8::Gemm g{CKV, WUKV, T, 1024, 256}; pg8::StaticOrder S; S.init(T, 1024, G, bx); EpiMlaKV E{KF, VB, SSQ};
          pg8::gemm_phase<EpiMlaKV, pg8::StaticOrder, true, true>(glds, g, S, E); }
        __syncthreads();
        if (!(P3SKIP & 2)) { pg8::Gemm g{CQ, WUQ, T, 768, 256}; pg8::StaticOrder S; S.init(T, 768, G, bx); EpiMlaQ E{QB, SSQ, CS};
          pg8::gemm_phase<EpiMlaQ, pg8::StaticOrder, true, true>(glds, g, S, E); }
        __syncthreads();
        if (!(P3SKIP & 4)) for (int it = bx; it < 256; it += G) att::ret_chunk_kv(lds, RK, RV, KVT, it >> 5, it & 31, args.log2g[(it >> 5) & 3]);
    }
    SEAM(3);
    if (IN(4)) {
        for (int e = bx * 512 + tid; e < 8 * 16384; e += G * 512) { const int bh = e >> 14, idx = e & 16383;
            const float cd = __builtin_amdgcn_exp2f(128.0f * args.log2g[bh & 3]); float st = 0.f;
            const float* kp = KVT + (size_t)bh * 64 * 16384 + idx; bf16* pp = PREVT + (size_t)bh * 64 * 16384 + idx;
#pragma unroll 8
            for (int c = 0; c < 64; ++c) { pp[(size_t)c * 16384] = (bf16)f2bf(st); st = st * cd + kp[(size_t)c * 16384]; } }
        for (int it = bx; it < 256; it += G) { const int bh = it & 7, pi = it >> 3;
            att::attn_block(lds, QB, KF, VB, YCAT, bh >> 2, bh & 3, 63 - pi);
            att::attn_block(lds, QB, KF, VB, YCAT, bh >> 2, bh & 3, pi); }
    }
    SEAM(4);
    if (IN(5)) {
        for (int it = bx; it < 256; it += G) att::ret_out(lds, RQ, RK, RV, RG, PREVT, ret_gn_w, YCAT, it >> 5, it & 31, args.log2g[(it >> 5) & 3]);
    }
    SEAM(5);
    if (IN(6)) {
        pg8::Gemm g{YCAT, WOUT, T, D, D}; pg8::StaticOrder S; S.init(T, D, G, bx); EpiResid E{x, V1, MOD + 2048};
        pg8::gemm_phase<EpiResid, pg8::StaticOrder, true, true>(glds, g, S, E);
    }
    SEAM(6);
    if (IN(7)) {
        for (int row = gw; row < T; row += NGW) {
            const f32x4* xr = (const f32x4*)(V1 + (size_t)row * D) + lane; const float* md = MOD + (row >> 13) * 6144;
            f32x4 v[4]; float s = 0.f;
#pragma unroll
            for (int j = 0; j < 4; ++j) { v[j] = xr[64 * j]; s += (v[j][0] + v[j][1]) + (v[j][2] + v[j][3]); }
            float mean = wave_sum(s) * (1.f / D), s2 = 0.f;
#pragma unroll
            for (int j = 0; j < 4; ++j) { v[j] = v[j] - mean; s2 += (v[j][0] * v[j][0] + v[j][1] * v[j][1]) + (v[j][2] * v[j][2] + v[j][3] * v[j][3]); }
            float rstd = 1.f / sqrtf(wave_sum(s2) * (1.f / D) + 1e-5f);
            f32x4* xo = (f32x4*)(out + (size_t)row * D) + lane; s = 0.f;
#pragma unroll
            for (int j = 0; j < 4; ++j) { const int c = 4 * lane + 256 * j; v[j] = v[j] * rstd * *(const f32x4*)(ln1_w + c) + *(const f32x4*)(ln1_b + c); xo[64 * j] = v[j]; s += (v[j][0] + v[j][1]) + (v[j][2] + v[j][3]); }
            mean = wave_sum(s) * (1.f / D); s2 = 0.f;
#pragma unroll
            for (int j = 0; j < 4; ++j) { v[j] = v[j] - mean; s2 += (v[j][0] * v[j][0] + v[j][1] * v[j][1]) + (v[j][2] * v[j][2] + v[j][3] * v[j][3]); }
            rstd = 1.f / sqrtf(wave_sum(s2) * (1.f / D) + 1e-5f);
            u32x2* o8 = (u32x2*)(H2 + (size_t)row * D) + lane;
#pragma unroll
            for (int j = 0; j < 4; ++j) { const int c = 4 * lane + 256 * j; const f32x4 sh = *(const f32x4*)(md + 3072 + c), sc = *(const f32x4*)(md + 4096 + c);
                const f32x4 y = v[j] * rstd * (sc + 1.0f) + sh; u32x2 w; w.x = pk2(y[0], y[1]); w.y = pk2(y[2], y[3]); o8[64 * j] = w; }
        }
    }
    SEAM(7);
    if (IN(8)) {
        pg8::Gemm g{H2 - 2 * D, WUP, 66 * 256, NUP, D}; pg8::StaticOrder S; S.init(66 * 256, NUP, G, bx); EpiUpConv E{ACT, conv_w, conv_b};
        pg8::gemm_phase<EpiUpConv, pg8::StaticOrder, true, true, true>(glds, g, S, E);
    }
    SEAM(8);
    if (IN(9)) {
        pg8::Gemm g{ACT, WDOWN, T, D, DFF}; pg8::StaticOrder S; S.init(T, D, G, bx); EpiResid E{out, out, MOD + 5120};
        pg8::gemm_phase<EpiResid, pg8::StaticOrder, true, true>(glds, g, S, E);
    }
    SEAM(9);
    if (IN(10)) {
        for (int row = gw; row < T; row += NGW) {
            f32x4* xr = (f32x4*)(out + (size_t)row * D) + lane;
            f32x4 v[4]; float s = 0.f;
#pragma unroll
            for (int j = 0; j < 4; ++j) { v[j] = xr[64 * j]; s += (v[j][0] + v[j][1]) + (v[j][2] + v[j][3]); }
            const float mean = wave_sum(s) * (1.f / D); float s2 = 0.f;
#pragma unroll
            for (int j = 0; j < 4; ++j) { v[j] = v[j] - mean; s2 += (v[j][0] * v[j][0] + v[j][1] * v[j][1]) + (v[j][2] * v[j][2] + v[j][3] * v[j][3]); }
            const float rstd = 1.f / sqrtf(wave_sum(s2) * (1.f / D) + 1e-5f);
#pragma unroll
            for (int j = 0; j < 4; ++j) { const int c = 4 * lane + 256 * j; xr[64 * j] = v[j] * rstd * *(const f32x4*)(ln2_w + c) + *(const f32x4*)(ln2_b + c); }
        }
    }

#ifdef DBG_CHECK
    {
        grid.sync();
        unsigned* flags = (unsigned*)(ws + 480 * 1024);
        for (int sidx = gw; sidx < 64 * 6; sidx += NGW) {
            const int chk = sidx / 64, si = sidx % 64;
            unsigned hh = (unsigned)(si * 7919 + chk * 104729 + 12345); hh ^= hh >> 16; hh *= 0x7feb352dU; hh ^= hh >> 15; hh *= 0x846ca68bU; hh ^= hh >> 16;
            float got = 0.f, ref = 0.f;
            if (chk == 0) { const int b = hh & 1, n = (hh >> 1) % 6144; float a = 0.f;
                for (int k = lane; k < D; k += 64) a += siluf(cvec[b * D + k]) * w_ada[(size_t)k * 6144 + n];
                ref = wave_sum(a) + b_ada[n]; got = MOD[b * 6144 + n]; }
            else if (chk == 1) { const int row = hh % T, col = (hh >> 14) % D; float a = 0.f;
                for (int k = lane; k < D; k += 64) a += bf2f(YCAT[(size_t)row * D + k]) * w_out[(size_t)k * D + col];
                ref = DN_ALPHA * x[(size_t)row * D + col] + (1.0f + MOD[(row >> 13) * 6144 + 2048 + col]) * wave_sum(a); got = V1[(size_t)row * D + col]; }
            else {
                int t, j = (hh >> 14) % DFF;
                if (chk == 2 || chk == 3) t = hh % T; else if (chk == 4) t = 126 * (hh % 130) + ((hh >> 8) % 3); else t = (hh & 1) * SEQ + ((hh >> 8) % 3);
                const int pos = t & (SEQ - 1); float cgv = conv_b[j], cvv = conv_b[DFF + j];
                for (int dt = 0; dt < 3; ++dt) { if (pos - 2 + dt < 0) continue; const int tt = t - 2 + dt; float ag = 0.f, av = 0.f;
                    for (int k = lane; k < D; k += 64) { const float hv = bf2f(H2[(size_t)tt * D + k]); ag += hv * w_up[(size_t)k * NUP + j]; av += hv * w_up[(size_t)k * NUP + DFF + j]; }
                    cgv += conv_w[dt * NUP + j] * wave_sum(ag); cvv += conv_w[dt * NUP + DFF + j] * wave_sum(av); }
                ref = siluf(cgv) * cvv; got = bf2f(ACT[(size_t)t * DFF + j]); }
            const float tol = 0.03f * fabsf(ref) + 0.03f;
            if (lane == 0 && !(fabsf(got - ref) <= tol)) atomicOr(flags, 1u << chk);
        }
        grid.sync();
        if (bx == 0 && tid == 0) out[0] = 1000.f * (float)(*flags + 1);
    }
#endif
#undef IN
#undef SEAM
}

#ifndef MK_MULTI
#define MK_MULTI 0
#endif
extern "C" void kernel_launch(void* const* d_in, const int* in_sizes, int n_in, void* d_out, int out_size, void* d_ws, size_t ws_size, hipStream_t stream) {
    static int grid = 0;
    if (grid == 0) {
        int dev = 0, cus = 0, per_cu = 0;
        (void)hipGetDevice(&dev); (void)hipDeviceGetAttribute(&cus, hipDeviceAttributeMultiprocessorCount, dev);
        (void)hipFuncSetAttribute((const void*)fwd_kernel, hipFuncAttributeMaxDynamicSharedMemorySize, LDS_BYTES);
        (void)hipOccupancyMaxActiveBlocksPerMultiprocessor(&per_cu, (const void*)fwd_kernel, 512, LDS_BYTES);
        if (per_cu < 1) { fprintf(stderr, "kernel_launch: occupancy query says %d blocks per CU\n", per_cu); per_cu = 1; }
        grid = cus * per_cu;
        if (n_in != 19 || ws_size < 256 * MiB) fprintf(stderr, "kernel_launch: unexpected n_in %d / ws_size %zu\n", n_in, ws_size);
    }
    (void)hipMemsetAsync((char*)d_ws, 0, WS_ZERO_BYTES, stream);
    Args a{};
    for (int i = 0; i < 19; ++i) a.in[i] = (const float*)d_in[i];
    a.out = (float*)d_out; a.ws = (unsigned char*)d_ws;
    for (int i = 0; i < 64; ++i) a.inv_freq[i] = pow(10000.0, -(double)i / 64.0);
    for (int h = 0; h < 4; ++h) a.log2g[h] = (float)(log1p(-pow(2.0, -5.0 - h)) / log(2.0));
#if MK_MULTI
    for (int p = 0; p < NPHASE; ++p) { a.ph_lo = p; a.ph_hi = p + 1; void* kargs[] = {&a};
        hipError_t e = hipLaunchCooperativeKernel((const void*)fwd_kernel, dim3(grid), dim3(512), kargs, LDS_BYTES, stream);
        if (e != hipSuccess) fprintf(stderr, "launch phase %d failed: %s\n", p, hipGetErrorString(e)); }
#else
#ifdef DBG_CHECK
    a.ph_lo = 0; a.ph_hi = 9; void* kargs[] = {&a};
#else
    a.ph_lo = 0; a.ph_hi = NPHASE; void* kargs[] = {&a};
#endif
    hipError_t e = hipLaunchCooperativeKernel((const void*)fwd_kernel, dim3(grid), dim3(512), kargs, LDS_BYTES, stream);
    if (e != hipSuccess) fprintf(stderr, "cooperative launch failed: %s (grid %d)\n", hipGetErrorString(e), grid);
#endif
}
```

```cpp
#include <hip/hip_runtime.h>
#include <hip/hip_cooperative_groups.h>
#include <cstdio>
#include <cstdint>
#include <cmath>
namespace cg = cooperative_groups;

namespace pg8 {
#define PG8_LAS __attribute__((address_space(3)))
typedef unsigned short bf16_t;
typedef short bf16x8 __attribute__((ext_vector_type(8)));
typedef float f32x4 __attribute__((ext_vector_type(4)));
typedef unsigned u32x4 __attribute__((ext_vector_type(4)));
typedef unsigned u32x2 __attribute__((ext_vector_type(2)));
constexpr int BM = 256, BK = 64, HALF = 128, HTB = HALF * BK * 2  , STAGE_BYTES = 8 * HTB, NXCD = 8, WGM = 8;

__host__ __device__ __forceinline__ int lds_byte(int r, int c) { const int st = (r >> 4) * 2 + (c >> 5), rr = r & 15, cc = c & 31, ob = rr * 64 + cc * 2; return st * 1024 + (ob ^ (((ob >> 9) & 1) << 5)); }
__host__ __device__ __forceinline__ void stage_rc(int b, int& R, int& C) { const int st = b / 1024, sb = b % 1024, swz = sb ^ (((sb >> 9) & 1) << 5); R = (st >> 1) * 16 + swz / 64; C = (st & 1) * 32 + (swz % 64) / 2; }
__host__ __device__ __forceinline__ int perm32(int rho) { const int n = rho >> 4, i = rho & 15; return 8 * (i >> 2) + 4 * n + (i & 3); }

struct Unit { int pm, pn; };
struct Gemm { const bf16_t* A; const bf16_t* Bt; int M, N, K; };

struct StaticOrder {
    int nM, nN, nwg, G, c;
    __host__ __device__ void init(int M, int N, int G_, int c_) { nM = M / BM; nN = N / BM; nwg = nM * nN; G = G_; c = c_; }
    __host__ __device__ bool next(int i, Unit& u) const {
        const long L = (long)i * G + c; if (L >= nwg) return false;
        int wgid = (int)L; { const int q = nwg / NXCD, r = nwg % NXCD, xcd = wgid % NXCD, off = wgid / NXCD; wgid = (xcd < r ? xcd * (q + 1) : r * (q + 1) + (xcd - r) * q) + off; }
        const int nig = WGM * nN, gid = wgid / nig, fm = gid * WGM, gsz = (nM - fm) < WGM ? (nM - fm) : WGM;
        u.pm = fm + ((wgid % nig) % gsz); u.pn = (wgid % nig) / gsz; return true;
    }
    __device__ __forceinline__ void a_ready(const Unit&) const {}
    __device__ __forceinline__ void done(const Unit&) const {}
};
__device__ __forceinline__ unsigned cvt_pk_bf16(float lo, float hi) { unsigned r; asm volatile("v_cvt_pk_bf16_f32 %0, %1, %2" : "=v"(r) : "v"(lo), "v"(hi)); return r; }
template <class Epi, class Sched, bool ALIGN_EPI = false, bool SP2 = false, bool AMAP = false>
__device__ __forceinline__ void gemm_phase(PG8_LAS unsigned char* lds, const Gemm g, const Sched& S, const Epi& E) {
    const int tid = threadIdx.x, wid = __builtin_amdgcn_readfirstlane(tid >> 6), lane = tid & 63, wr = wid >> 2, wc = wid & 3, fr = lane & 15, fq = lane >> 4;
    const int K = g.K, nt = K / BK;
    unsigned voffA[2], voffB[2];
#pragma unroll
    for (int i = 0; i < 2; ++i) { int R, C; stage_rc(tid * 16 + i * 8192, R, C); const int Rb = Epi::PERM ? ((R & ~31) + perm32(R & 31)) : R;
        const int Ra = AMAP ? ((R >> 6) * 126 + (R & 15) * 8 + ((R >> 4) & 3)) : R; voffA[i] = (unsigned)(Ra * K + C) * 2u; voffB[i] = (unsigned)(Rb * K + C) * 2u; }
    const size_t kstep = (size_t)(BK * 2);
    const size_t hstep = (size_t)HALF * K * 2;
    const size_t tstep = 2 * hstep;
    const size_t hstepA = AMAP ? (size_t)4 * K * 2 : hstep, tstepA = AMAP ? (size_t)252 * K * 2 : tstep;
    const unsigned ldsw = (unsigned)wid * 1024u;
    const int aoff = lds_byte(wr * 64 + fr, fq * 8), boff = lds_byte(wc * 32 + fr, fq * 8);
#define PG8_SA(b, h) (((b) * 2 + (h)) * HTB)
#define PG8_SB(b, h) ((4 + (b) * 2 + (h)) * HTB)
#define PG8_STAGE(bufoff, gbase, voff) do { _Pragma("unroll") for (int _i = 0; _i < 2; ++_i) \
        __builtin_amdgcn_global_load_lds((const unsigned*)((const char*)(gbase) + (voff)[_i]), (PG8_LAS unsigned*)(lds + (bufoff) + ldsw + _i * 8192), 16, 0, 0); } while (0)
#define PG8_LDA(dst, b, h) do { _Pragma("unroll") for (int m = 0; m < 4; ++m) _Pragma("unroll") for (int k = 0; k < 2; ++k) dst[m][k] = *(const PG8_LAS bf16x8*)(lds + PG8_SA(b, h) + aoff + m * 2048 + k * 1024); } while (0)
#define PG8_LDB(dst, b, h) do { _Pragma("unroll") for (int n = 0; n < 2; ++n) _Pragma("unroll") for (int k = 0; k < 2; ++k) dst[n][k] = *(const PG8_LAS bf16x8*)(lds + PG8_SB(b, h) + boff + n * 2048 + k * 1024); } while (0)
#define PG8_MMA(ai, bj, At, Bt) do { __builtin_amdgcn_s_setprio(1); _Pragma("unroll") for (int m = 0; m < 4; ++m) _Pragma("unroll") for (int n = 0; n < 2; ++n) _Pragma("unroll") for (int k = 0; k < 2; ++k) \
        acc[ai][bj][m][n] = __builtin_amdgcn_mfma_f32_16x16x32_bf16(Bt[n][k], At[m][k], acc[ai][bj][m][n], 0, 0, 0); __builtin_amdgcn_s_setprio(0); } while (0)
#define PG8_WAIT_V(n) asm volatile("s_waitcnt vmcnt(" #n ")" ::: "memory")
#define PG8_WAIT_L(n) asm volatile("s_waitcnt lgkmcnt(" #n ")" ::: "memory")
#define PG8_BAR __builtin_amdgcn_s_barrier()
#define PG8_SCHED __builtin_amdgcn_sched_barrier(0)
    Unit cur, nxt; int ui = 0;
    if (!S.next(0, cur)) return;
    f32x4 acc[2][2][4][2];
#pragma unroll
    for (int a = 0; a < 2; ++a)
#pragma unroll
        for (int b = 0; b < 2; ++b)
#pragma unroll
            for (int m = 0; m < 4; ++m)
#pragma unroll
                for (int n = 0; n < 2; ++n) acc[a][b][m][n] = (f32x4){0.f, 0.f, 0.f, 0.f};
    bf16x8 At[4][2], B0[2][2], B1[2][2];
    const char* cA = (const char*)g.A + (size_t)cur.pm * tstepA; const char* cB = (const char*)g.Bt + (size_t)cur.pn * tstep;
    S.a_ready(cur);
    if constexpr (SP2) {
        PG8_STAGE(PG8_SB(0, 0), cB, voffB); PG8_STAGE(PG8_SB(0, 1), cB + hstep, voffB); PG8_STAGE(PG8_SA(0, 0), cA, voffA); PG8_STAGE(PG8_SA(0, 1), cA + hstepA, voffA);
        if (wr == 1) PG8_BAR;
        PG8_WAIT_V(2); PG8_BAR;
        PG8_STAGE(PG8_SB(1, 0), cB + kstep, voffB); PG8_STAGE(PG8_SA(1, 0), cA + kstep, voffA); PG8_STAGE(PG8_SB(1, 1), cB + hstep + kstep, voffB);
        PG8_WAIT_V(6); PG8_BAR;
    } else {
        PG8_STAGE(PG8_SB(0, 0), cB, voffB); PG8_STAGE(PG8_SA(0, 0), cA, voffA); PG8_STAGE(PG8_SB(0, 1), cB + hstep, voffB); PG8_STAGE(PG8_SA(0, 1), cA + hstepA, voffA);
        if (wr == 1) PG8_BAR;
        PG8_WAIT_V(4); PG8_BAR;
        PG8_STAGE(PG8_SB(1, 0), cB + kstep, voffB); PG8_STAGE(PG8_SA(1, 0), cA + kstep, voffA); PG8_STAGE(PG8_SB(1, 1), cB + hstep + kstep, voffB);
        PG8_WAIT_V(6); PG8_BAR;
    }
    for (;;) {
        const bool has_next = S.next(ui + 1, nxt);
        const char* nA = has_next ? (const char*)g.A + (size_t)nxt.pm * tstepA : cA; const char* nB = has_next ? (const char*)g.Bt + (size_t)nxt.pn * tstep : cB;
#pragma unroll 1
        for (int t = 0; t < nt; t += 2) {
            const bool last = (t == nt - 2);
            const char* a1 = cA + (size_t)(t + 1) * kstep;
            const char* a2 = last ? nA : cA + (size_t)(t + 2) * kstep; const char* b2 = last ? nB : cB + (size_t)(t + 2) * kstep;
            const char* a3 = a2 + kstep; const char* b3 = b2 + kstep;
            if (last && has_next) S.a_ready(nxt);
            if constexpr (SP2) {
            PG8_LDB(B0, 0, 0); PG8_LDB(B1, 0, 1); PG8_SCHED; PG8_LDA(At, 0, 0); PG8_STAGE(PG8_SA(1, 1), a1 + hstepA, voffA);
            PG8_WAIT_V(8); PG8_WAIT_L(0); PG8_BAR; PG8_MMA(0, 0, At, B0); PG8_MMA(0, 1, At, B1); PG8_BAR; PG8_SCHED;
            PG8_LDA(At, 0, 1); PG8_STAGE(PG8_SB(0, 0), b2, voffB); PG8_STAGE(PG8_SB(0, 1), b2 + hstep, voffB); PG8_STAGE(PG8_SA(0, 0), a2, voffA);
            PG8_WAIT_V(8); PG8_WAIT_L(0); PG8_BAR; PG8_MMA(1, 0, At, B0); PG8_MMA(1, 1, At, B1); PG8_BAR; PG8_SCHED;
            PG8_LDB(B0, 1, 0); PG8_LDB(B1, 1, 1); PG8_SCHED; PG8_LDA(At, 1, 0); PG8_STAGE(PG8_SA(0, 1), a2 + hstepA, voffA);
            PG8_WAIT_V(8); PG8_WAIT_L(0); PG8_BAR; PG8_MMA(0, 0, At, B0); PG8_MMA(0, 1, At, B1); PG8_BAR; PG8_SCHED;
            PG8_LDA(At, 1, 1); PG8_STAGE(PG8_SB(1, 0), b3, voffB); PG8_STAGE(PG8_SB(1, 1), b3 + hstep, voffB); PG8_STAGE(PG8_SA(1, 0), a3, voffA);
            PG8_WAIT_V(8); PG8_WAIT_L(0); PG8_BAR; PG8_MMA(1, 0, At, B0); PG8_MMA(1, 1, At, B1); PG8_BAR; PG8_SCHED;
            } else {
            PG8_LDB(B0, 0, 0); PG8_SCHED; PG8_LDA(At, 0, 0); PG8_STAGE(PG8_SA(1, 1), a1 + hstepA, voffA);
            PG8_WAIT_L(8); PG8_BAR; PG8_WAIT_L(0); PG8_MMA(0, 0, At, B0); PG8_BAR; PG8_SCHED;
            PG8_LDB(B1, 0, 1); PG8_STAGE(PG8_SB(0, 0), b2, voffB);
            PG8_BAR; PG8_WAIT_L(0); PG8_MMA(0, 1, At, B1); PG8_BAR;
            PG8_LDA(At, 0, 1); PG8_STAGE(PG8_SA(0, 0), a2, voffA);
            PG8_BAR; PG8_WAIT_L(0); PG8_MMA(1, 0, At, B0); PG8_BAR; PG8_SCHED;
            PG8_STAGE(PG8_SB(0, 1), b2 + hstep, voffB);
            PG8_WAIT_V(6); PG8_BAR; PG8_MMA(1, 1, At, B1); PG8_BAR;
            PG8_LDB(B0, 1, 0); PG8_SCHED; PG8_LDA(At, 1, 0); PG8_STAGE(PG8_SA(0, 1), a2 + hstepA, voffA);
            PG8_WAIT_L(8); PG8_BAR; PG8_WAIT_L(0); PG8_MMA(0, 0, At, B0); PG8_BAR; PG8_SCHED;
            PG8_LDB(B1, 1, 1); PG8_STAGE(PG8_SB(1, 0), b3, voffB);
            PG8_BAR; PG8_WAIT_L(0); PG8_MMA(0, 1, At, B1); PG8_BAR;
            PG8_LDA(At, 1, 1); PG8_STAGE(PG8_SA(1, 0), a3, voffA);
            PG8_BAR; PG8_WAIT_L(0); PG8_MMA(1, 0, At, B0); PG8_BAR; PG8_SCHED;
            PG8_STAGE(PG8_SB(1, 1), b3 + hstep, voffB);
            PG8_WAIT_V(6); PG8_BAR; PG8_MMA(1, 1, At, B1); PG8_BAR;
            }
        }
        if constexpr (ALIGN_EPI) { if (wr == 0) PG8_BAR; }
        if constexpr (!Epi::AFTER_DRAIN) { E(acc, cur, wr, wc, fr, fq); S.done(cur); }
        if (!has_next) break;
#pragma unroll
        for (int a = 0; a < 2; ++a)
#pragma unroll
            for (int b = 0; b < 2; ++b)
#pragma unroll
                for (int m = 0; m < 4; ++m)
#pragma unroll
                    for (int n = 0; n < 2; ++n) acc[a][b][m][n] = (f32x4){0.f, 0.f, 0.f, 0.f};
        cur = nxt; cA = nA; cB = nB; ++ui;
        if constexpr (ALIGN_EPI) { if (wr == 1) PG8_BAR; }
    }
    PG8_WAIT_V(0);
    if constexpr (!ALIGN_EPI) { if (wr == 0) PG8_BAR; }
    PG8_BAR;
    if constexpr (Epi::AFTER_DRAIN) { E.fused(acc, cur, wr, wc, fr, fq, lds, wid, lane); S.done(cur); }
#undef PG8_SA
#undef PG8_SB
#undef PG8_STAGE
#undef PG8_LDA
#undef PG8_LDB
#undef PG8_MMA
#undef PG8_WAIT_V
#undef PG8_WAIT_L
#undef PG8_BAR
#undef PG8_SCHED
}
}

#define DEVI __device__ __forceinline__
typedef unsigned short bf16;
typedef short bf16x8 __attribute__((ext_vector_type(8)));
typedef short s16x4 __attribute__((ext_vector_type(4)));
typedef float f32x16 __attribute__((ext_vector_type(16)));
typedef float f32x4 __attribute__((ext_vector_type(4)));
typedef float f32x2 __attribute__((ext_vector_type(2)));
typedef unsigned u32x4 __attribute__((ext_vector_type(4)));
typedef unsigned u32x2 __attribute__((ext_vector_type(2)));

constexpr int SEQ = 8192, NB = 2, T = NB * SEQ, D = 1024, NIN = 2624, NINP = 2816, DFF = 2816, NUP = 5632;
constexpr float DN_ALPHA = 1.189207115002721f;
constexpr float QSCALE = 0.07216878364870323f * 1.4426950408889634f;
constexpr float RK_SCALE = 0.08838834764831845f;
constexpr size_t MiB = 1u << 20;
constexpr size_t WS_SSQ = 0, WS_MOD = 256 * 1024, WS_BAR = 384 * 1024, WS_ZERO_BYTES = 512 * 1024;
constexpr size_t WS_CS = 1 * MiB;
constexpr size_t WS_WIN = 5 * MiB, WS_WUQ = 11 * MiB, WS_WUKV = 11 * MiB + 512 * 1024, WS_WOUT = 12 * MiB, WS_WUP = 14 * MiB, WS_WDOWN = 25 * MiB;
constexpr size_t WS_H1 = 32 * MiB, WS_YCAT = 32 * MiB;
constexpr size_t WS_RQ = 64 * MiB, WS_RK = 80 * MiB, WS_RV = 96 * MiB, WS_RG = 112 * MiB, WS_V1 = 64 * MiB;
constexpr size_t WS_CQ = 128 * MiB, WS_CKV = 136 * MiB, WS_QB = 144 * MiB, WS_KF = 168 * MiB, WS_VB = 192 * MiB, WS_KVT = 208 * MiB, WS_PREVT = 240 * MiB;
constexpr size_t WS_H2 = 130 * MiB, WS_ACT = 162 * MiB;
constexpr int LDS_BYTES = 147456;
constexpr int NPHASE = 11;

struct Args {
    const float* in[19]; float* out; unsigned char* ws;
    double inv_freq[64];
    float log2g[4];
    int ph_lo, ph_hi;
};

DEVI unsigned f2bf(float f) { unsigned u = __builtin_bit_cast(unsigned, f); return (u + 0x7fffu + ((u >> 16) & 1u)) >> 16; }
DEVI unsigned pk2(float lo, float hi) { return pg8::cvt_pk_bf16(lo, hi); }
DEVI float bf2f(unsigned short b) { return __builtin_bit_cast(float, ((unsigned)b) << 16); }
DEVI float bflo(unsigned w) { return __builtin_bit_cast(float, w << 16); }
DEVI float bfhi(unsigned w) { return __builtin_bit_cast(float, w & 0xffff0000u); }
DEVI float wave_sum(float v) {
#pragma unroll
    for (int o = 1; o < 64; o <<= 1) v += __shfl_xor(v, o);
    return v;
}
DEVI float siluf(float x) { return x * __builtin_amdgcn_rcpf(1.0f + __builtin_amdgcn_exp2f(-x * 1.4426950408889634f)); }
DEVI unsigned lds_addr(const void* p) { return (unsigned)(uintptr_t)p; }

enum { WK_IN = 0, WK_UQ = 1, WK_UKV = 2, WK_OUT = 3, WK_UP = 4, WK_DOWN = 5 };
DEVI int wsrc(int kind, int np) {
    if (kind == WK_IN) {
        if (np < 1024) { const int seg = np & ~511, h = (np >> 7) & 3, j = np & 127; return seg + h * 128 + (j >> 1) + 64 * (j & 1); }
        if (np < 2560) return np;
        if (np < 2624) { const int j = np - 2560; return 2560 + (j >> 1) + 32 * (j & 1); }
        return -1;
    }
    if (kind == WK_UQ) { const int h = np / 192, j = np - h * 192; if (j < 128) return np; const int jj = j - 128; return h * 192 + 128 + (jj >> 1) + 32 * (jj & 1); }
    if (kind == WK_UP) { const int pn = np >> 8, bj = (np >> 7) & 1, j = np & 127; return bj * DFF + 128 * pn + j; }
    return np;
}
DEVI void p0_transpose_item(int kind, const float* W, int K, int N, int NP, bf16* WT, const float* kscale, float* scr, int item, int lane) {
    const int nblk = NP / 32, kb = item / nblk, nb = item % nblk, k0 = 64 * kb, n0 = 32 * nb;
    const int np = n0 + (lane & 31), src = wsrc(kind, np);
    const float cs = (kind == WK_IN && np >= 512 && np < 1024) ? RK_SCALE : (kind == WK_UQ ? QSCALE : 1.0f);
#pragma unroll 8
    for (int i = 0; i < 32; ++i) { const int kk = 2 * i + (lane >> 5);
        float v = src >= 0 ? W[(size_t)(k0 + kk) * N + src] * cs : 0.f;
        if (kscale) v *= kscale[k0 + kk];
        scr[kk * 33 + (lane & 31)] = v; }
    asm volatile("s_waitcnt lgkmcnt(0)" ::: "memory");
    const int c = lane & 7;
#pragma unroll
    for (int j = 0; j < 4; ++j) { const int n = (lane >> 3) + 8 * j; const float* s = scr + (8 * c) * 33 + n;
        u32x4 o; o.x = pk2(s[0 * 33], s[1 * 33]); o.y = pk2(s[2 * 33], s[3 * 33]); o.z = pk2(s[4 * 33], s[5 * 33]); o.w = pk2(s[6 * 33], s[7 * 33]);
        *(u32x4*)(WT + (size_t)(n0 + n) * K + k0 + 8 * c) = o; }
    asm volatile("s_waitcnt lgkmcnt(0)" ::: "memory");
}

using pg8::Unit;
typedef const f32x4 (&AccRef)[2][2][4][2];

DEVI void rope4(f32x4& v0, f32x4& v1, const f32x2* cs, int stride) {
    const f32x2 c0 = cs[0], c1 = cs[stride], c2 = cs[2 * stride], c3 = cs[3 * stride];
    f32x4 a = v0, b = v1;
    v0[0] = a[0] * c0.x - a[1] * c0.y; v0[1] = a[1] * c0.x + a[0] * c0.y;
    v0[2] = a[2] * c1.x - a[3] * c1.y; v0[3] = a[3] * c1.x + a[2] * c1.y;
    v1[0] = b[0] * c2.x - b[1] * c2.y; v1[1] = b[1] * c2.x + b[0] * c2.y;
    v1[2] = b[2] * c3.x - b[3] * c3.y; v1[3] = b[3] * c3.x + b[2] * c3.y;
}
DEVI u32x4 pack8(const f32x4& v0, const f32x4& v1) { u32x4 w; w.x = pk2(v0[0], v0[1]); w.y = pk2(v0[2], v0[3]); w.z = pk2(v1[0], v1[1]); w.w = pk2(v1[2], v1[3]); return w; }

struct EpiInProj {
    static constexpr bool PERM = true, AFTER_DRAIN = false;
    bf16 *RQ, *RK, *RV, *RG, *CQ, *CKV, *KF; float* SSQ; const f32x2* CS;
    DEVI void operator()(AccRef acc, const Unit& u, int wr, int wc, int fr, int fq) const {
        const int pn = u.pn, row0 = u.pm * 256 + wr * 64 + fr, cl = wc * 32 + 8 * fq;
#pragma unroll
        for (int ai = 0; ai < 2; ++ai)
#pragma unroll
            for (int m = 0; m < 4; ++m) {
                const int row = row0 + ai * 128 + m * 16, pos = row & (SEQ - 1);
                float ss = 0.f;
#pragma unroll
                for (int bj = 0; bj < 2; ++bj) {
                    f32x4 v0 = acc[ai][bj][m][0], v1 = acc[ai][bj][m][1];
                    const int c = pn * 256 + bj * 128 + cl;
                    if (pn < 4) {
                        const int cc = c & 511;
                        rope4(v0, v1, CS + (size_t)pos * 64 + ((cc & 127) >> 1), 1);
                        *(u32x4*)((pn < 2 ? RQ : RK) + (size_t)row * 512 + cc) = pack8(v0, v1);
                    } else if (pn < 8) {
                        *(u32x4*)((pn < 6 ? RV : RG) + (size_t)row * 512 + (c & 511)) = pack8(v0, v1);
                    } else if (pn < 10) {
                        *(u32x4*)((pn == 8 ? CQ : CKV) + (size_t)row * 256 + (c & 255)) = pack8(v0, v1);
                        ss += (v0[0] * v0[0] + v0[1] * v0[1]) + (v0[2] * v0[2] + v0[3] * v0[3]) + (v1[0] * v1[0] + v1[1] * v1[1]) + (v1[2] * v1[2] + v1[3] * v1[3]);
                    } else if (c < NIN) {
                        const int j = c - 2560;
                        rope4(v0, v1, CS + (size_t)pos * 64 + j, 2);
                        const u32x4 w = pack8(v0, v1);
#pragma unroll
                        for (int h = 0; h < 4; ++h) *(u32x4*)(KF + (size_t)row * 768 + h * 192 + 128 + j) = w;
                    }
                }
                if (pn == 8 || pn == 9) { ss += __shfl_xor(ss, 16); ss += __shfl_xor(ss, 32); if (fq == 0) atomicAdd(SSQ + (size_t)row * 2 + (pn - 8), ss); }
                asm volatile("" ::: "memory");
            }
    }
};
struct EpiMlaQ {
    static constexpr bool PERM = true, AFTER_DRAIN = false;
    bf16* QB; const float* SSQ; const f32x2* CS;
    DEVI void operator()(AccRef acc, const Unit& u, int wr, int wc, int fr, int fq) const {
        const int row0 = u.pm * 256 + wr * 64 + fr, cl = wc * 32 + 8 * fq;
#pragma unroll
        for (int ai = 0; ai < 2; ++ai)
#pragma unroll
            for (int m = 0; m < 4; ++m) {
                const int row = row0 + ai * 128 + m * 16, pos = row & (SEQ - 1);
                const float rstd = 1.0f / sqrtf(SSQ[(size_t)row * 2] * (1.0f / 256.0f) + 1e-6f);
#pragma unroll
                for (int bj = 0; bj < 2; ++bj) {
                    f32x4 v0 = acc[ai][bj][m][0] * rstd, v1 = acc[ai][bj][m][1] * rstd;
                    const int c = u.pn * 256 + bj * 128 + cl, h = c / 192, j = c - h * 192;
                    if (j >= 128) rope4(v0, v1, CS + (size_t)pos * 64 + (j - 128), 2);
                    *(u32x4*)(QB + (size_t)row * 768 + c) = pack8(v0, v1);
                }
                asm volatile("" ::: "memory");
            }
    }
};
struct EpiMlaKV {
    static constexpr bool PERM = true, AFTER_DRAIN = false;
    bf16 *KF, *VB; const float* SSQ;
    DEVI void operator()(AccRef acc, const Unit& u, int wr, int wc, int fr, int fq) const {
        const int row0 = u.pm * 256 + wr * 64 + fr, cl = wc * 32 + 8 * fq, h = u.pn;
#pragma unroll
        for (int ai = 0; ai < 2; ++ai)
#pragma unroll
            for (int m = 0; m < 4; ++m) {
                const int row = row0 + ai * 128 + m * 16;
                const float rstd = 1.0f / sqrtf(SSQ[(size_t)row * 2 + 1] * (1.0f / 256.0f) + 1e-6f);
                { f32x4 v0 = acc[ai][0][m][0] * rstd, v1 = acc[ai][0][m][1] * rstd; *(u32x4*)(KF + (size_t)row * 768 + h * 192 + cl) = pack8(v0, v1); }
                { f32x4 v0 = acc[ai][1][m][0] * rstd, v1 = acc[ai][1][m][1] * rstd; *(u32x4*)(VB + (size_t)row * 512 + h * 128 + cl) = pack8(v0, v1); }
                asm volatile("" ::: "memory");
            }
    }
};
struct EpiResid {
    static constexpr bool PERM = false, AFTER_DRAIN = false;
    const float* res; float* dst; const float* gate;
    DEVI void operator()(AccRef acc, const Unit& u, int wr, int wc, int fr, int fq) const {
        const int row0 = u.pm * 256 + wr * 64 + fr, col0 = u.pn * 256 + wc * 32 + 4 * fq;
#pragma unroll
        for (int ai = 0; ai < 2; ++ai)
#pragma unroll
            for (int m = 0; m < 4; ++m) {
                const int row = row0 + ai * 128 + m * 16; const float* g = gate + (row >> 13) * (6 * D);
#pragma unroll
                for (int bj = 0; bj < 2; ++bj)
#pragma unroll
                    for (int n = 0; n < 2; ++n) {
                        const int c = col0 + bj * 128 + n * 16; const size_t off = (size_t)row * D + c;
                        const f32x4 r = *(const f32x4*)(res + off), gg = *(const f32x4*)(g + c);
                        *(f32x4*)(dst + off) = r * DN_ALPHA + (gg + 1.0f) * acc[ai][bj][m][n];
                    }
                asm volatile("" ::: "memory");
            }
    }
};
DEVI float dpp_shr1_f(float x) { float r; asm volatile("s_nop 1\n\tv_mov_b32_dpp %0, %1 row_shr:1 row_mask:0xf bank_mask:0xf bound_ctrl:1" : "=v"(r) : "v"(x)); return r; }
DEVI f32x4 dpp_shr1(const f32x4& v) { f32x4 r; r[0] = dpp_shr1_f(v[0]); r[1] = dpp_shr1_f(v[1]); r[2] = dpp_shr1_f(v[2]); r[3] = dpp_shr1_f(v[3]); return r; }
struct EpiUpConv {
    static constexpr bool PERM = true, AFTER_DRAIN = false;
    bf16* ACT; const float* cw; const float* cb;
    DEVI void operator()(AccRef acc, const Unit& u, int wr, int wc, int fr, int fq) const {
        const int tok0 = u.pm * 252 - 2 + wr * 126 + fr * 8, colg = u.pn * 128 + wc * 32 + 8 * fq;
#pragma unroll
        for (int n = 0; n < 2; ++n) {
            const int cg4 = colg + 4 * n;
            const f32x4 w0g = *(const f32x4*)(cw + cg4), w1g = *(const f32x4*)(cw + NUP + cg4), w2g = *(const f32x4*)(cw + 2 * NUP + cg4), bg = *(const f32x4*)(cb + cg4);
            const f32x4 w0v = *(const f32x4*)(cw + DFF + cg4), w1v = *(const f32x4*)(cw + NUP + DFF + cg4), w2v = *(const f32x4*)(cw + 2 * NUP + DFF + cg4), bv = *(const f32x4*)(cb + DFF + cg4);
            f32x4 g1 = dpp_shr1(acc[1][0][3][n]), g2 = dpp_shr1(acc[1][0][2][n]);
            f32x4 v1 = dpp_shr1(acc[1][1][3][n]), v2 = dpp_shr1(acc[1][1][2][n]);
#pragma unroll
            for (int k = 0; k < 8; ++k) {
                const f32x4 ug = acc[k >> 2][0][k & 3][n], uv = acc[k >> 2][1][k & 3][n];
                const int t = tok0 + k, pos = t & (SEQ - 1);
                f32x4 a1 = g1, a2 = g2, b1 = v1, b2 = v2;
                if (pos < 1) { a1 = (f32x4){0.f, 0.f, 0.f, 0.f}; b1 = a1; }
                if (pos < 2) { a2 = (f32x4){0.f, 0.f, 0.f, 0.f}; b2 = a2; }
                const f32x4 cgv = bg + w2g * ug + w1g * a1 + w0g * a2, cvv = bv + w2v * uv + w1v * b1 + w0v * b2;
                g2 = g1; g1 = ug; v2 = v1; v1 = uv;
                if (t < T && !(fr == 0 && k < 2)) {
                    u32x2 w; w.x = pk2(siluf(cgv[0]) * cvv[0], siluf(cgv[1]) * cvv[1]); w.y = pk2(siluf(cgv[2]) * cvv[2], siluf(cgv[3]) * cvv[3]);
                    *(u32x2*)(ACT + (size_t)t * DFF + cg4) = w;
                }
            }
        }
    }
};

namespace att {
constexpr int KT = 64 * 192 * 2, VT = 64 * 128 * 2, BUF = KT + VT;
DEVI int v_st(int k, int c) { const int kk = (k & ~0xC) | ((k & 4) << 1) | ((k & 8) >> 1); return ((kk >> 3) * 4 + (c >> 5)) * 512 + ((kk & 7) * 32 + (c & 31)) * 2; }
DEVI int v_rd_base(int lane) { return ((lane & 3) << 3) | (((lane >> 2) & 3) << 6) | (((lane >> 4) & 1) << 5) | (((lane >> 5) & 1) << 8); }
constexpr int v_rd_off(int d0, int ks, int half) { return d0 * 512 + ks * 4096 + half * 2048; }
DEVI int crow(int r, int hi) { return (r & 3) + 8 * (r >> 2) + 4 * hi; }
#define ATT_PK4(P, B_, OUT) do { unsigned a0 = pk2(P[B_+0], P[B_+1]), a1 = pk2(P[B_+2], P[B_+3]);                          \
        unsigned b0 = pk2(P[B_+4], P[B_+5]), b1 = pk2(P[B_+6], P[B_+7]);                                             \
        auto r0 = __builtin_amdgcn_permlane32_swap(a0, b0, false, false); auto r1 = __builtin_amdgcn_permlane32_swap(a1, b1, false, false); \
        u32x4 w = {r0[0], r1[0], r0[1], r1[1]}; OUT = __builtin_bit_cast(bf16x8, w); } while (0)
#define ATT_TRRD(dst, base, off) asm volatile("ds_read_b64_tr_b16 %0, %1 offset:%2" : "=&v"(dst) : "v"(base), "i"(off) : "memory")
#define ATT_MK8(l, h) ((bf16x8){l[0], l[1], l[2], l[3], h[0], h[1], h[2], h[3]})
DEVI float swapmax(float v) { auto rr = __builtin_amdgcn_permlane32_swap(__float_as_uint(v), __float_as_uint(v), false, false); return fmaxf(__uint_as_float(rr[0]), __uint_as_float(rr[1])); }
DEVI float swapsum(float v) { auto rr = __builtin_amdgcn_permlane32_swap(__float_as_uint(v), __float_as_uint(v), false, false); return __uint_as_float(rr[0]) + __uint_as_float(rr[1]); }

DEVI void attn_block(char* lds, const bf16* QB, const bf16* KF, const bf16* VB, bf16* Y, int b, int h, int qb) {
    const int tid = threadIdx.x, wid = __builtin_amdgcn_readfirstlane(tid >> 6), lane = tid & 63, r32 = lane & 31, hi = lane >> 5, qg = wid & 3, kh = wid >> 2;
    const int q0 = qb * 128, NT = 2 * (qb + 1);
    const size_t tokb = (size_t)b * SEQ;
    bf16x8 qr[12];
    { const bf16* qp = QB + (tokb + q0 + qg * 32 + r32) * 768 + h * 192 + hi * 8;
#pragma unroll
      for (int d0 = 0; d0 < 12; ++d0) qr[d0] = *(const bf16x8*)(qp + d0 * 16); }
    int kgo[3], klo[3];
#pragma unroll
    for (int i = 0; i < 3; ++i) { const int q = tid + 512 * i, row = q / 24, ch = q - row * 24; kgo[i] = row * 768 + ch * 8; klo[i] = row * 384 + ((ch ^ (row & 7)) << 4); }
    const int sr = tid >> 4, sc = (tid & 15) * 8;
    const int vgo0 = sr * 512 + sc, vgo1 = (32 + sr) * 512 + sc, vlo0 = KT + v_st(sr, sc), vlo1 = KT + v_st(32 + sr, sc);
    const bf16* Kg = KF + tokb * 768 + h * 192; const bf16* Vg = VB + tokb * 512 + h * 128;
    bf16x8 sk0, sk1, sk2, sv0, sv1;
#define ATT_LOADT(t) do { const bf16* kp_ = Kg + (size_t)(t) * (64 * 768); const bf16* vp_ = Vg + (size_t)(t) * (64 * 512); \
        sk0 = *(const bf16x8*)(kp_ + kgo[0]); sk1 = *(const bf16x8*)(kp_ + kgo[1]); sk2 = *(const bf16x8*)(kp_ + kgo[2]); sv0 = *(const bf16x8*)(vp_ + vgo0); sv1 = *(const bf16x8*)(vp_ + vgo1); } while (0)
#define ATT_WRITET(bf) do { char* b_ = lds + (bf) * BUF; *(bf16x8*)(b_ + klo[0]) = sk0; *(bf16x8*)(b_ + klo[1]) = sk1; *(bf16x8*)(b_ + klo[2]) = sk2; *(bf16x8*)(b_ + vlo0) = sv0; *(bf16x8*)(b_ + vlo1) = sv1; } while (0)
    ATT_LOADT(0); ATT_WRITET(0); __syncthreads();
    float m_reg = -1e30f, l_reg = 0.f; f32x16 o[4];
#pragma unroll
    for (int d0 = 0; d0 < 4; ++d0) o[d0] = (f32x16){};
    const int ksw = r32 & 7, kro = (kh * 32 + r32) * 384;
    int kx[4];
#pragma unroll
    for (int bq = 0; bq < 4; ++bq) kx[bq] = kro + (((2 * bq + hi) ^ ksw) << 4);
    const unsigned vb_base = lds_addr(lds) + KT + v_rd_base(lane) + kh * 8192;
    const int qabs = q0 + qg * 32 + r32;
    for (int t = 0; t < NT; ++t) {
        const int cur = t & 1;
        if (t + 1 < NT) ATT_LOADT(t + 1);
        f32x16 p = (f32x16){};
        { const char* kb = lds + cur * BUF;
#pragma unroll
          for (int d0 = 0; d0 < 12; ++d0) { const bf16x8 kf = *(const bf16x8*)(kb + kx[d0 & 3] + (d0 >> 2) * 128); p = __builtin_amdgcn_mfma_f32_32x32x16_bf16(kf, qr[d0], p, 0, 0, 0); } }
        if (t >= NT - 2) { const int dq = qabs - (t * 64 + kh * 32) - 4 * hi; const float NEG = -__builtin_inff();
#pragma unroll
            for (int r = 0; r < 16; ++r) { const int c = (r & 3) + 8 * (r >> 2); if (c > dq) p[r] = NEG; } }
        float pmax = p[0];
#pragma unroll
        for (int r = 1; r < 16; ++r) pmax = fmaxf(pmax, p[r]);
        pmax = swapmax(pmax);
        float alpha, mn;
        if (__builtin_expect(__all(pmax - m_reg <= 8.0f), 1)) { mn = m_reg; alpha = 1.f; }
        else { mn = fmaxf(m_reg, pmax); alpha = __builtin_amdgcn_exp2f(m_reg - mn); m_reg = mn; }
#pragma unroll
        for (int r = 0; r < 16; ++r) p[r] = __builtin_amdgcn_exp2f(p[r] - mn);
        float ps = 0.f;
#pragma unroll
        for (int r = 0; r < 16; ++r) ps += p[r];
        ps = swapsum(ps);
        l_reg = l_reg * alpha + ps;
        bf16x8 pa0, pa1; ATT_PK4(p, 0, pa0); ATT_PK4(p, 8, pa1);
        if (__any(alpha < 1.f)) {
#pragma unroll
            for (int d0 = 0; d0 < 4; ++d0) o[d0] = o[d0] * alpha; }
        { const unsigned vb = vb_base + cur * BUF;
#pragma unroll
          for (int d0 = 0; d0 < 4; ++d0) { s16x4 l0, h0, l1, h1;
            ATT_TRRD(l0, vb, d0 * 512); ATT_TRRD(h0, vb, d0 * 512 + 2048); ATT_TRRD(l1, vb, d0 * 512 + 4096); ATT_TRRD(h1, vb, d0 * 512 + 6144);
            asm volatile("s_waitcnt lgkmcnt(0)" ::: "memory"); __builtin_amdgcn_sched_barrier(0);
            o[d0] = __builtin_amdgcn_mfma_f32_32x32x16_bf16(ATT_MK8(l0, h0), pa0, o[d0], 0, 0, 0);
            o[d0] = __builtin_amdgcn_mfma_f32_32x32x16_bf16(ATT_MK8(l1, h1), pa1, o[d0], 0, 0, 0); } }
        if (t + 1 < NT) ATT_WRITET(cur ^ 1);
        __syncthreads();
    }
    float* cmb = (float*)lds + qg * (66 * 64) + lane;
    if (kh == 1) {
#pragma unroll
        for (int d0 = 0; d0 < 4; ++d0)
#pragma unroll
            for (int r = 0; r < 16; ++r) cmb[(d0 * 16 + r) * 64] = o[d0][r];
        cmb[64 * 64] = m_reg; cmb[65 * 64] = l_reg;
    }
    __syncthreads();
    if (kh == 0) {
        const float m1 = cmb[64 * 64], l1 = cmb[65 * 64], mn = fmaxf(m_reg, m1), a0 = __builtin_amdgcn_exp2f(m_reg - mn), a1 = __builtin_amdgcn_exp2f(m1 - mn);
        const float inv = 1.0f / (l_reg * a0 + l1 * a1), s0 = a0 * inv, s1 = a1 * inv;
        bf16* yp = Y + (tokb + q0 + qg * 32 + r32) * 1024 + 512 + h * 128 + 4 * hi;
#pragma unroll
        for (int d0 = 0; d0 < 4; ++d0)
#pragma unroll
            for (int g = 0; g < 4; ++g) { float v[4];
#pragma unroll
                for (int j = 0; j < 4; ++j) v[j] = o[d0][4 * g + j] * s0 + cmb[(d0 * 16 + 4 * g + j) * 64] * s1;
                u32x2 w; w.x = pk2(v[0], v[1]); w.y = pk2(v[2], v[3]);
#ifdef DBG_ZERO_MLA
                w.x = 0; w.y = 0;
#endif
                *(u32x2*)(yp + d0 * 32 + 8 * g) = w; }
    }
    __syncthreads();
#undef ATT_LOADT
#undef ATT_WRITET
}

DEVI void stage_chunk(char* dst, const bf16* src, int t2, float scale_l2g) {
#pragma unroll
    for (int i = 0; i < 8; ++i) { const int s = t2 + 256 * i, k = s >> 4, c = (s & 15) * 8;
        u32x4 w = *(const u32x4*)(src + (size_t)k * 512 + c);
        if (scale_l2g != 0.f) { const float f = __builtin_amdgcn_exp2f((float)(127 - k) * scale_l2g);
            w.x = pk2(bflo(w.x) * f, bfhi(w.x) * f); w.y = pk2(bflo(w.y) * f, bfhi(w.y) * f); w.z = pk2(bflo(w.z) * f, bfhi(w.z) * f); w.w = pk2(bflo(w.w) * f, bfhi(w.w) * f); }
        *(u32x4*)(dst + (k >> 6) * 16384 + v_st(k & 63, c)) = w; }
}
DEVI void ret_chunk_kv(char* lds, const bf16* RK, const bf16* RV, float* KVT, int bh, int cp, float l2g) {
    const int tid = threadIdx.x, wid = __builtin_amdgcn_readfirstlane(tid >> 6), lane = tid & 63, r32 = lane & 31, hi = lane >> 5, half = wid >> 2, et = wid & 3;
    const int b = bh >> 2, h = bh & 3, c = 2 * cp + half;
    const size_t tok0 = (size_t)b * SEQ + c * 128;
    char* Vs = lds + half * 65536; char* Ks = Vs + 32768;
    stage_chunk(Vs, RV + tok0 * 512 + h * 128, tid & 255, 0.f);
    stage_chunk(Ks, RK + tok0 * 512 + h * 128, tid & 255, l2g);
    __syncthreads();
    f32x16 acc[4];
#pragma unroll
    for (int dt = 0; dt < 4; ++dt) acc[dt] = (f32x16){};
    const unsigned vb = lds_addr(Vs) + v_rd_base(lane) + et * 512, kb = lds_addr(Ks) + v_rd_base(lane);
#pragma unroll
    for (int ks = 0; ks < 8; ++ks) {
        s16x4 vl, vh, kl[4], khh[4];
        ATT_TRRD(vl, vb, ks * 4096); ATT_TRRD(vh, vb, ks * 4096 + 2048);
#pragma unroll
        for (int dt = 0; dt < 4; ++dt) { ATT_TRRD(kl[dt], kb, dt * 512 + ks * 4096); ATT_TRRD(khh[dt], kb, dt * 512 + ks * 4096 + 2048); }
        asm volatile("s_waitcnt lgkmcnt(0)" ::: "memory"); __builtin_amdgcn_sched_barrier(0);
        const bf16x8 vf = ATT_MK8(vl, vh);
#pragma unroll
        for (int dt = 0; dt < 4; ++dt) acc[dt] = __builtin_amdgcn_mfma_f32_32x32x16_bf16(vf, ATT_MK8(kl[dt], khh[dt]), acc[dt], 0, 0, 0);
    }
    float* out = KVT + ((size_t)(bh * 64 + c) * 128 + et * 32) * 128 + r32;
#pragma unroll
    for (int dt = 0; dt < 4; ++dt)
#pragma unroll
        for (int r = 0; r < 16; ++r) out[(size_t)crow(r, hi) * 128 + dt * 32] = acc[dt][r];
    __syncthreads();
}
DEVI void ret_out(char* lds, const bf16* RQ, const bf16* RK, const bf16* RV, const bf16* RG, const bf16* PREVT, const float* gnw, bf16* Y, int bh, int cp, float l2g) {
    const int tid = threadIdx.x, wid = __builtin_amdgcn_readfirstlane(tid >> 6), lane = tid & 63, r32 = lane & 31, hi = lane >> 5, half = wid >> 2, nb = wid & 3;
    const int b = bh >> 2, h = bh & 3, c = 2 * cp + half;
    const size_t tok0 = (size_t)b * SEQ + c * 128;
    char* Vs = lds + half * 32768;
    stage_chunk(Vs, RV + tok0 * 512 + h * 128, tid & 255, 0.f);
    bf16x8 qf[8];
    { const bf16* qp = RQ + (tok0 + nb * 32 + r32) * 512 + h * 128 + hi * 8;
#pragma unroll
      for (int d0 = 0; d0 < 8; ++d0) qf[d0] = *(const bf16x8*)(qp + d0 * 16); }
    f32x16 o[4];
#pragma unroll
    for (int et = 0; et < 4; ++et) o[et] = (f32x16){};
    { const bf16* pp = PREVT + (size_t)(bh * 64 + c) * 16384 + (size_t)r32 * 128 + hi * 8;
#pragma unroll
      for (int et = 0; et < 4; ++et)
#pragma unroll
        for (int d0 = 0; d0 < 8; ++d0) { const bf16x8 pf = *(const bf16x8*)(pp + et * 32 * 128 + d0 * 16); o[et] = __builtin_amdgcn_mfma_f32_32x32x16_bf16(pf, qf[d0], o[et], 0, 0, 0); } }
    const int nl = nb * 32 + r32;
    { const float qw = __builtin_amdgcn_exp2f((float)(nl + 1) * l2g);
#pragma unroll
      for (int et = 0; et < 4; ++et) o[et] = o[et] * qw; }
    __syncthreads();
    const unsigned vb = lds_addr(Vs) + v_rd_base(lane);
#pragma unroll
    for (int mt = 0; mt < 4; ++mt) {
        if (mt <= nb) {
            f32x16 p = (f32x16){};
            const bf16* kp = RK + (tok0 + mt * 32 + r32) * 512 + h * 128 + hi * 8;
#pragma unroll
            for (int d0 = 0; d0 < 8; ++d0) { const bf16x8 kf = *(const bf16x8*)(kp + d0 * 16); p = __builtin_amdgcn_mfma_f32_32x32x16_bf16(kf, qf[d0], p, 0, 0, 0); }
#pragma unroll
            for (int r = 0; r < 16; ++r) { const int dl = nl - (mt * 32 + crow(r, hi)); p[r] = dl >= 0 ? p[r] * __builtin_amdgcn_exp2f((float)dl * l2g) : 0.f; }
            bf16x8 pa0, pa1; ATT_PK4(p, 0, pa0); ATT_PK4(p, 8, pa1);
#pragma unroll
            for (int et = 0; et < 4; ++et) { s16x4 l0, h0, l1, h1;
                ATT_TRRD(l0, vb, et * 512 + (2 * mt) * 4096); ATT_TRRD(h0, vb, et * 512 + (2 * mt) * 4096 + 2048);
                ATT_TRRD(l1, vb, et * 512 + (2 * mt + 1) * 4096); ATT_TRRD(h1, vb, et * 512 + (2 * mt + 1) * 4096 + 2048);
                asm volatile("s_waitcnt lgkmcnt(0)" ::: "memory"); __builtin_amdgcn_sched_barrier(0);
                o[et] = __builtin_amdgcn_mfma_f32_32x32x16_bf16(ATT_MK8(l0, h0), pa0, o[et], 0, 0, 0);
                o[et] = __builtin_amdgcn_mfma_f32_32x32x16_bf16(ATT_MK8(l1, h1), pa1, o[et], 0, 0, 0); }
        }
    }
    float s = 0.f;
#pragma unroll
    for (int et = 0; et < 4; ++et)
#pragma unroll
        for (int r = 0; r < 16; ++r) s += o[et][r];
    const float mean = swapsum(s) * (1.0f / 128.0f);
    float q = 0.f;
#pragma unroll
    for (int et = 0; et < 4; ++et)
#pragma unroll
        for (int r = 0; r < 16; ++r) { const float d = o[et][r] - mean; q += d * d; }
    const float rstd = 1.0f / sqrtf(swapsum(q) * (1.0f / 128.0f) + 1e-5f);
    const size_t tok = tok0 + nl;
    const bf16* gp = RG + tok * 512 + h * 128 + 4 * hi; const float* wp = gnw + h * 128 + 4 * hi; bf16* yp = Y + tok * 1024 + h * 128 + 4 * hi;
#pragma unroll
    for (int et = 0; et < 4; ++et)
#pragma unroll
        for (int g = 0; g < 4; ++g) { const int e = et * 32 + 8 * g;
            const u32x2 gw = *(const u32x2*)(gp + e); const f32x4 ww = *(const f32x4*)(wp + e);
            const float g0 = siluf(bflo(gw.x)), g1 = siluf(bfhi(gw.x)), g2 = siluf(bflo(gw.y)), g3 = siluf(bfhi(gw.y));
            u32x2 w; w.x = pk2((o[et][4 * g] - mean) * rstd * ww[0] * g0, (o[et][4 * g + 1] - mean) * rstd * ww[1] * g1);
            w.y = pk2((o[et][4 * g + 2] - mean) * rstd * ww[2] * g2, (o[et][4 * g + 3] - mean) * rstd * ww[3] * g3);
            *(u32x2*)(yp + e) = w; }
    __syncthreads();
}
}

#define LAS __attribute__((address_space(3)))
#define XB_TMO      128
#define XB_XCNT(j)  (256  + 64 * (j))
#define XB_XSUB(j)  (1280 + 64 * (j))
#define XB_XGEN(j)  (2304 + 64 * (j))
#define XB_TOP      3328
#define XB_TOPGEN   3392
#define XCD_BAR_WORDS 3456
#define XB_SPIN_CAP (1u << 18)

__device__ __forceinline__ unsigned xb_ld(unsigned* p)              { return __hip_atomic_load(p, __ATOMIC_RELAXED, __HIP_MEMORY_SCOPE_AGENT); }
__device__ __forceinline__ unsigned xb_add(unsigned* p, unsigned v) { return __hip_atomic_fetch_add(p, v, __ATOMIC_RELAXED, __HIP_MEMORY_SCOPE_AGENT); }
__device__ __forceinline__ unsigned xb_xcc_id() { return (unsigned)__builtin_amdgcn_s_getreg((3 << 11) | 20) & 0xFu; }
#define XB_SPIN(cond, bar) do { unsigned _sp = 0; while (cond) { __builtin_amdgcn_s_sleep(1); \
    if ((++_sp & 255u) == 0u) { if (xb_ld(&(bar)[XB_TMO])) break; if (_sp > XB_SPIN_CAP) { atomicAdd(&(bar)[XB_TMO], 1u); break; } } } } while (0)

struct XcdBarrier {
    unsigned* bar; unsigned x;
    volatile LAS unsigned* st;
};

__device__ __forceinline__ XcdBarrier xcd_barrier_post(unsigned* bar, volatile LAS unsigned* st) {
    XcdBarrier b; b.bar = bar; b.x = xb_xcc_id(); b.st = st;
    if (threadIdx.x == 0) (void)xb_add(&bar[XB_XCNT(b.x)], 1u);
    return b;
}
__device__ __forceinline__ void xcd_barrier_complete(unsigned* bar, unsigned x, unsigned& nloc, unsigned& nx) {
    const unsigned G = gridDim.x * gridDim.y * gridDim.z;
    unsigned sum, cnt, mine, sp = 0u;
    for (;;) {
        sum = 0u; cnt = 0u; mine = 0u;
#pragma unroll
        for (unsigned j = 0; j < 16; ++j) { const unsigned c = xb_ld(&bar[XB_XCNT(j)]); sum += c; cnt += (c > 0u) ? 1u : 0u; mine = (j == x) ? c : mine; }
        if (sum == G) break;
        __builtin_amdgcn_s_sleep(1);
        if ((++sp & 255u) == 0u) { if (xb_ld(&bar[XB_TMO])) break; if (sp > XB_SPIN_CAP) { atomicAdd(&bar[XB_TMO], 1u); break; } }
    }
    nloc = mine > 0u ? mine : 1u; nx = cnt > 0u ? cnt : 1u;
}

__device__ __forceinline__ void xcd_barrier(const XcdBarrier& b) {
    asm volatile("s_waitcnt vmcnt(0)" ::: "memory");
    __syncthreads();
    if (threadIdx.x == 0) {
        unsigned* bar = b.bar;
        __builtin_amdgcn_s_waitcnt(0);
        unsigned nloc = b.st[0], nx = b.st[1];
        if (nloc == 0u) { xcd_barrier_complete(bar, b.x, nloc, nx); b.st[0] = nloc; b.st[1] = nx; }
        const unsigned old = xb_add(&bar[XB_XSUB(b.x)], 1u);
        const unsigned gen = old / nloc;
        if (old + 1u == (gen + 1u) * nloc) {
            __builtin_amdgcn_fence(__ATOMIC_RELEASE, "agent");
            asm volatile("s_waitcnt vmcnt(0)" ::: "memory");
            const unsigned og = xb_add(&bar[XB_TOP], 1u);
            const unsigned tg = og / nx;
            if (og + 1u == (tg + 1u) * nx) xb_add(&bar[XB_TOPGEN], 1u);
            else XB_SPIN(xb_ld(&bar[XB_TOPGEN]) == tg, bar);
            __builtin_amdgcn_fence(__ATOMIC_ACQUIRE, "agent");
            xb_add(&bar[XB_XGEN(b.x)], 1u);
            asm volatile("s_waitcnt vmcnt(0)" ::: "memory");
        } else {
            XB_SPIN(xb_ld(&bar[XB_XGEN(b.x)]) == gen, bar);
            __builtin_amdgcn_fence(__ATOMIC_ACQUIRE, "agent");
            asm volatile("s_waitcnt vmcnt(0)" ::: "memory");
        }
    }
    __syncthreads();
}

__global__ void __launch_bounds__(512, 2) fwd_kernel(Args args) {
    extern __shared__ __attribute__((aligned(16))) char lds[];
    cg::grid_group grid = cg::this_grid();
    const int tid = threadIdx.x, lane = tid & 63, wave = __builtin_amdgcn_readfirstlane(tid >> 6);
    const int G = gridDim.x, bx = blockIdx.x;
    const int gw = bx * 8 + wave, NGW = G * 8;
    unsigned char* ws = args.ws;
    const float* x = args.in[0]; const float* cvec = args.in[1]; const float* w_ada = args.in[2]; const float* b_ada = args.in[3];
    const float* w_in = args.in[4]; const float* ret_gn_w = args.in[5]; const float* q_norm_w = args.in[6]; const float* w_uq = args.in[7];
    const float* kv_norm_w = args.in[8]; const float* w_ukv = args.in[9]; const float* w_out = args.in[10]; const float* ln1_w = args.in[11]; const float* ln1_b = args.in[12];
    const float* w_up = args.in[13]; const float* conv_w = args.in[14]; const float* conv_b = args.in[15]; const float* w_down = args.in[16]; const float* ln2_w = args.in[17]; const float* ln2_b = args.in[18];
    float* SSQ = (float*)(ws + WS_SSQ); float* MOD = (float*)(ws + WS_MOD); f32x2* CS = (f32x2*)(ws + WS_CS);
    bf16* WIN = (bf16*)(ws + WS_WIN); bf16* WUQ = (bf16*)(ws + WS_WUQ); bf16* WUKV = (bf16*)(ws + WS_WUKV); bf16* WOUT = (bf16*)(ws + WS_WOUT); bf16* WUP = (bf16*)(ws + WS_WUP); bf16* WDOWN = (bf16*)(ws + WS_WDOWN);
    bf16* H1 = (bf16*)(ws + WS_H1); bf16* YCAT = (bf16*)(ws + WS_YCAT);
    bf16* RQ = (bf16*)(ws + WS_RQ); bf16* RK = (bf16*)(ws + WS_RK); bf16* RV = (bf16*)(ws + WS_RV); bf16* RG = (bf16*)(ws + WS_RG); float* V1 = (float*)(ws + WS_V1);
    bf16* CQ = (bf16*)(ws + WS_CQ); bf16* CKV = (bf16*)(ws + WS_CKV); bf16* QB = (bf16*)(ws + WS_QB); bf16* KF = (bf16*)(ws + WS_KF); bf16* VB = (bf16*)(ws + WS_VB);
    float* KVT = (float*)(ws + WS_KVT); bf16* PREVT = (bf16*)(ws + WS_PREVT); bf16* H2 = (bf16*)(ws + WS_H2); bf16* ACT = (bf16*)(ws + WS_ACT);
    float* out = args.out;
    PG8_LAS unsigned char* glds = (PG8_LAS unsigned char*)lds;
    const int lo = args.ph_lo, hi_ph = args.ph_hi;
    if (tid < 64) ((unsigned*)(lds + 131072))[tid] = 0u;
    __syncthreads();
    const XcdBarrier xbar = xcd_barrier_post((unsigned*)(ws + WS_BAR), (volatile LAS unsigned*)(lds + 131072 + 64));
    if (lo > 1000) grid.sync();
#ifndef PHMASK
#define PHMASK 0x7ff
#endif
#define IN(k) (((PHMASK >> (k)) & 1) && lo <= (k) && (k) < hi_ph)
#define SEAM(k) do { if (IN(k) && IN((k) + 1)) xcd_barrier(xbar); } while (0)

    if (IN(0)) {
        float* scr = (float*)lds + wave * 4096;
        constexpr int I_IN = 16 * (NINP / 32), I_UQ = 4 * 24, I_UKV = 4 * 32, I_OUT = 16 * 32, I_UP = 16 * (NUP / 32), I_DOWN = 44 * 32;
        constexpr int NT0 = I_IN + I_UQ + I_UKV + I_OUT + I_UP + I_DOWN;
        for (int it = gw; it < NT0; it += NGW) {
            int r = it;
            if (r < I_UP) { p0_transpose_item(WK_UP, w_up, D, NUP, NUP, WUP, nullptr, scr, r, lane); continue; } r -= I_UP;
            if (r < I_IN) { p0_transpose_item(WK_IN, w_in, D, NIN, NINP, WIN, nullptr, scr, r, lane); continue; } r -= I_IN;
            if (r < I_DOWN) { p0_transpose_item(WK_DOWN, w_down, DFF, D, D, WDOWN, nullptr, scr, r, lane); continue; } r -= I_DOWN;
            if (r < I_OUT) { p0_transpose_item(WK_OUT, w_out, D, D, D, WOUT, nullptr, scr, r, lane); continue; } r -= I_OUT;
            if (r < I_UKV) { p0_transpose_item(WK_UKV, w_ukv, 256, 1024, 1024, WUKV, kv_norm_w, scr, r, lane); continue; } r -= I_UKV;
            p0_transpose_item(WK_UQ, w_uq, 256, 768, 768, WUQ, q_norm_w, scr, r, lane);
        }
        for (int it = gw; it < 32 * 24; it += NGW) {
            const int ksl = it / 24, nt = it % 24, n = nt * 256 + lane * 4;
            f32x4 a0 = (f32x4){0.f, 0.f, 0.f, 0.f}, a1 = a0;
            if (ksl == 0) { a0 = *(const f32x4*)(b_ada + n); a1 = a0; }
#pragma unroll 8
            for (int kk = 0; kk < 32; ++kk) { const int k = ksl * 32 + kk; const f32x4 w = *(const f32x4*)(w_ada + (size_t)k * 6144 + n);
                a0 += w * siluf(cvec[k]); a1 += w * siluf(cvec[D + k]); }
#pragma unroll
            for (int j = 0; j < 4; ++j) { atomicAdd(MOD + n + j, a0[j]); atomicAdd(MOD + 6144 + n + j, a1[j]); }
        }
        for (int e = bx * 512 + tid; e < SEQ * 64; e += G * 512) { const int pos = e >> 6, i = e & 63;
            const double rev = (double)pos * args.inv_freq[i] * 0.15915494309189535; const float fr = (float)(rev - floor(rev));
            CS[e] = (f32x2){__builtin_amdgcn_cosf(fr), __builtin_amdgcn_sinf(fr)}; }
    }
    SEAM(0);
    if (IN(1)) {
        for (int row = gw; row < T; row += NGW) {
            const f32x4* xr = (const f32x4*)(x + (size_t)row * D) + lane; const float* md = MOD + (row >> 13) * 6144;
            f32x4 v[4]; float s = 0.f;
#pragma unroll
            for (int j = 0; j < 4; ++j) { v[j] = xr[64 * j]; s += (v[j][0] + v[j][1]) + (v[j][2] + v[j][3]); }
            const float mean = wave_sum(s) * (1.f / D); float s2 = 0.f;
#pragma unroll
            for (int j = 0; j < 4; ++j) { v[j] = v[j] - mean; s2 += (v[j][0] * v[j][0] + v[j][1] * v[j][1]) + (v[j][2] * v[j][2] + v[j][3] * v[j][3]); }
            const float rstd = 1.f / sqrtf(wave_sum(s2) * (1.f / D) + 1e-5f);
            u32x2* o8 = (u32x2*)(H1 + (size_t)row * D) + lane;
#pragma unroll
            for (int j = 0; j < 4; ++j) { const int c = 4 * lane + 256 * j; const f32x4 sh = *(const f32x4*)(md + c), sc = *(const f32x4*)(md + 1024 + c);
                const f32x4 y = v[j] * rstd * (sc + 1.0f) + sh; u32x2 w; w.x = pk2(y[0], y[1]); w.y = pk2(y[2], y[3]); o8[64 * j] = w; }
        }
    }
    SEAM(1);
    if (IN(2)) {
        pg8::Gemm g{H1, WIN, T, NINP, D}; pg8::StaticOrder S; S.init(T, NINP, G, bx);
        EpiInProj E{RQ, RK, RV, RG, CQ, CKV, KF, SSQ, CS};
        pg8::gemm_phase<EpiInProj, pg8::StaticOrder, true, true>(glds, g, S, E);
    }
    SEAM(2);
    if (IN(3)) {
#ifndef P3SKIP
#define P3SKIP 0
#endif
        if (!(P3SKIP & 1)) { pg8::Gemm g{CKV, WUKV, T, 1024, 256}; pg8::StaticOrder S; S.init(T, 1024, G, bx); EpiMlaKV E{KF, VB, SSQ};
          pg8::gemm_phase<EpiMlaKV, pg8::StaticOrder, true, true>(glds, g, S, E); }
        __syncthreads();
        if (!(P3SKIP & 2)) { pg8::Gemm g{CQ, WUQ, T, 768, 256}; pg8::StaticOrder S; S.init(T, 768, G, bx); EpiMlaQ E{QB, SSQ, CS};
          pg8::gemm_phase<EpiMlaQ, pg8::StaticOrder, true, true>(glds, g, S, E); }
        __syncthreads();
        if (!(P3SKIP & 4)) for (int it = bx; it < 256; it += G) att::ret_chunk_kv(lds, RK, RV, KVT, it >> 5, it & 31, args.log2g[(it >> 5) & 3]);
    }
    SEAM(3);
    if (IN(4)) {
        for (int e = bx * 512 + tid; e < 8 * 16384; e += G * 512) { const int bh = e >> 14, idx = e & 16383;
            const float cd = __builtin_amdgcn_exp2f(128.0f * args.log2g[bh & 3]); float st = 0.f;
            const float* kp = KVT + (size_t)bh * 64 * 16384 + idx; bf16* pp = PREVT + (size_t)bh * 64 * 16384 + idx;
#pragma unroll 8
            for (int c = 0; c < 64; ++c) { pp[(size_t)c * 16384] = (bf16)f2bf(st); st = st * cd + kp[(size_t)c * 16384]; } }
#ifndef REP_ATT
#define REP_ATT 1
#endif
        for (int rep = 0; rep < REP_ATT; ++rep)
        for (int it = bx; it < 256; it += G) { const int bh = it & 7, pi = it >> 3;
            att::attn_block(lds, QB, KF, VB, YCAT, bh >> 2, bh & 3, 63 - pi);
            att::attn_block(lds, QB, KF, VB, YCAT, bh >> 2, bh & 3, pi); }
    }
    SEAM(4);
    if (IN(5)) {
        for (int it = bx; it < 256; it += G) att::ret_out(lds, RQ, RK, RV, RG, PREVT, ret_gn_w, YCAT, it >> 5, it & 31, args.log2g[(it >> 5) & 3]);
    }
    SEAM(5);
    if (IN(6)) {
        pg8::Gemm g{YCAT, WOUT, T, D, D}; pg8::StaticOrder S; S.init(T, D, G, bx); EpiResid E{x, V1, MOD + 2048};
        pg8::gemm_phase<EpiResid, pg8::StaticOrder, true, true>(glds, g, S, E);
    }
    SEAM(6);
    if (IN(7)) {
        for (int row = gw; row < T; row += NGW) {
            const f32x4* xr = (const f32x4*)(V1 + (size_t)row * D) + lane; const float* md = MOD + (row >> 13) * 6144;
            f32x4 v[4]; float s = 0.f;
#pragma unroll
            for (int j = 0; j < 4; ++j) { v[j] = xr[64 * j]; s += (v[j][0] + v[j][1]) + (v[j][2] + v[j][3]); }
            float mean = wave_sum(s) * (1.f / D), s2 = 0.f;
#pragma unroll
            for (int j = 0; j < 4; ++j) { v[j] = v[j] - mean; s2 += (v[j][0] * v[j][0] + v[j][1] * v[j][1]) + (v[j][2] * v[j][2] + v[j][3] * v[j][3]); }
            float rstd = 1.f / sqrtf(wave_sum(s2) * (1.f / D) + 1e-5f);
            f32x4* xo = (f32x4*)(out + (size_t)row * D) + lane; s = 0.f;
#pragma unroll
            for (int j = 0; j < 4; ++j) { const int c = 4 * lane + 256 * j; v[j] = v[j] * rstd * *(const f32x4*)(ln1_w + c) + *(const f32x4*)(ln1_b + c); xo[64 * j] = v[j]; s += (v[j][0] + v[j][1]) + (v[j][2] + v[j][3]); }
            mean = wave_sum(s) * (1.f / D); s2 = 0.f;
#pragma unroll
            for (int j = 0; j < 4; ++j) { v[j] = v[j] - mean; s2 += (v[j][0] * v[j][0] + v[j][1] * v[j][1]) + (v[j][2] * v[j][2] + v[j][3] * v[j][3]); }
            rstd = 1.f / sqrtf(wave_sum(s2) * (1.f / D) + 1e-5f);
            u32x2* o8 = (u32x2*)(H2 + (size_t)row * D) + lane;
#pragma unroll
            for (int j = 0; j < 4; ++j) { const int c = 4 * lane + 256 * j; const f32x4 sh = *(const f32x4*)(md + 3072 + c), sc = *(const f32x4*)(md + 4096 + c);
                const f32x4 y = v[j] * rstd * (sc + 1.0f) + sh; u32x2 w; w.x = pk2(y[0], y[1]); w.y = pk2(y[2], y[3]); o8[64 * j] = w; }
        }
    }
    SEAM(7);
    if (IN(8)) {
        pg8::Gemm g{H2 - 2 * D, WUP, 66 * 256, NUP, D}; pg8::StaticOrder S; S.init(66 * 256, NUP, G, bx); EpiUpConv E{ACT, conv_w, conv_b};
        pg8::gemm_phase<EpiUpConv, pg8::StaticOrder, true, true, true>(glds, g, S, E);
    }
    SEAM(8);
    if (IN(9)) {
        pg8::Gemm g{ACT, WDOWN, T, D, DFF}; pg8::StaticOrder S; S.init(T, D, G, bx); EpiResid E{out, out, MOD + 5120};
        pg8::gemm_phase<EpiResid, pg8::StaticOrder, true, true>(glds, g, S, E);
    }
    SEAM(9);
    if (IN(10)) {
        for (int row = gw; row < T; row += NGW) {
            f32x4* xr = (f32x4*)(out + (size_t)row * D) + lane;
            f32x4 v[4]; float s = 0.f;
#pragma unroll
            for (int j = 0; j < 4; ++j) { v[j] = xr[64 * j]; s += (v[j][0] + v[j][1]) + (v[j][2] + v[j][3]); }
            const float mean = wave_sum(s) * (1.f / D); float s2 = 0.f;
#pragma unroll
            for (int j = 0; j < 4; ++j) { v[j] = v[j] - mean; s2 += (v[j][0] * v[j][0] + v[j][1] * v[j][1]) + (v[j][2] * v[j][2] + v[j][3] * v[j][3]); }
            const float rstd = 1.f / sqrtf(wave_sum(s2) * (1.f / D) + 1e-5f);
#pragma unroll
            for (int j = 0; j < 4; ++j) { const int c = 4 * lane + 256 * j; xr[64 * j] = v[j] * rstd * *(const f32x4*)(ln2_w + c) + *(const f32x4*)(ln2_b + c); }
        }
    }

#ifdef DBG_CHECK
    {
        grid.sync();
        unsigned* flags = (unsigned*)(ws + 480 * 1024);
        for (int sidx = gw; sidx < 64 * 6; sidx += NGW) {
            const int chk = sidx / 64, si = sidx % 64;
            unsigned hh = (unsigned)(si * 7919 + chk * 104729 + 12345); hh ^= hh >> 16; hh *= 0x7feb352dU; hh ^= hh >> 15; hh *= 0x846ca68bU; hh ^= hh >> 16;
            float got = 0.f, ref = 0.f;
            if (chk == 0) { const int b = hh & 1, n = (hh >> 1) % 6144; float a = 0.f;
                for (int k = lane; k < D; k += 64) a += siluf(cvec[b * D + k]) * w_ada[(size_t)k * 6144 + n];
                ref = wave_sum(a) + b_ada[n]; got = MOD[b * 6144 + n]; }
            else if (chk == 1) { const int row = hh % T, col = (hh >> 14) % D; float a = 0.f;
                for (int k = lane; k < D; k += 64) a += bf2f(YCAT[(size_t)row * D + k]) * w_out[(size_t)k * D + col];
                ref = DN_ALPHA * x[(size_t)row * D + col] + (1.0f + MOD[(row >> 13) * 6144 + 2048 + col]) * wave_sum(a); got = V1[(size_t)row * D + col]; }
            else {
                int t, j = (hh >> 14) % DFF;
                if (chk == 2 || chk == 3) t = hh % T; else if (chk == 4) t = 126 * (hh % 130) + ((hh >> 8) % 3); else t = (hh & 1) * SEQ + ((hh >> 8) % 3);
                const int pos = t & (SEQ - 1); float cgv = conv_b[j], cvv = conv_b[DFF + j];
                for (int dt = 0; dt < 3; ++dt) { if (pos - 2 + dt < 0) continue; const int tt = t - 2 + dt; float ag = 0.f, av = 0.f;
                    for (int k = lane; k < D; k += 64) { const float hv = bf2f(H2[(size_t)tt * D + k]); ag += hv * w_up[(size_t)k * NUP + j]; av += hv * w_up[(size_t)k * NUP + DFF + j]; }
                    cgv += conv_w[dt * NUP + j] * wave_sum(ag); cvv += conv_w[dt * NUP + DFF + j] * wave_sum(av); }
                ref = siluf(cgv) * cvv; got = bf2f(ACT[(size_t)t * DFF + j]); }
            const float tol = 0.03f * fabsf(ref) + 0.03f;
            if (lane == 0 && !(fabsf(got - ref) <= tol)) atomicOr(flags, 1u << chk);
        }
        grid.sync();
        if (bx == 0 && tid == 0) out[0] = 1000.f * (float)(*flags + 1);
    }
#endif
#undef IN
#undef SEAM
}

#ifndef MK_MULTI
#define MK_MULTI 0
#endif
extern "C" void kernel_launch(void* const* d_in, const int* in_sizes, int n_in, void* d_out, int out_size, void* d_ws, size_t ws_size, hipStream_t stream) {
    static int grid = 0;
    if (grid == 0) {
        int dev = 0, cus = 0, per_cu = 0;
        (void)hipGetDevice(&dev); (void)hipDeviceGetAttribute(&cus, hipDeviceAttributeMultiprocessorCount, dev);
        (void)hipFuncSetAttribute((const void*)fwd_kernel, hipFuncAttributeMaxDynamicSharedMemorySize, LDS_BYTES);
        (void)hipOccupancyMaxActiveBlocksPerMultiprocessor(&per_cu, (const void*)fwd_kernel, 512, LDS_BYTES);
        if (per_cu < 1) { fprintf(stderr, "kernel_launch: occupancy query says %d blocks per CU\n", per_cu); per_cu = 1; }
        grid = cus * per_cu;
        if (n_in != 19 || ws_size < 256 * MiB) fprintf(stderr, "kernel_launch: unexpected n_in %d / ws_size %zu\n", n_in, ws_size);
    }
    (void)hipMemsetAsync((char*)d_ws, 0, WS_ZERO_BYTES, stream);
    Args a{};
    for (int i = 0; i < 19; ++i) a.in[i] = (const float*)d_in[i];
    a.out = (float*)d_out; a.ws = (unsigned char*)d_ws;
    for (int i = 0; i < 64; ++i) a.inv_freq[i] = pow(10000.0, -(double)i / 64.0);
    for (int h = 0; h < 4; ++h) a.log2g[h] = (float)(log1p(-pow(2.0, -5.0 - h)) / log(2.0));
#if MK_MULTI
    for (int p = 0; p < NPHASE; ++p) { a.ph_lo = p; a.ph_hi = p + 1; void* kargs[] = {&a};
        hipError_t e = hipLaunchCooperativeKernel((const void*)fwd_kernel, dim3(grid), dim3(512), kargs, LDS_BYTES, stream);
        if (e != hipSuccess) fprintf(stderr, "launch phase %d failed: %s\n", p, hipGetErrorString(e)); }
#else
#ifdef DBG_CHECK
    a.ph_lo = 0; a.ph_hi = 9; void* kargs[] = {&a};
#else
    a.ph_lo = 0; a.ph_hi = NPHASE; void* kargs[] = {&a};
#endif
    hipError_t e = hipLaunchCooperativeKernel((const void*)fwd_kernel, dim3(grid), dim3(512), kargs, LDS_BYTES, stream);
    if (e != hipSuccess) fprintf(stderr, "cooperative launch failed: %s (grid %d)\n", hipGetErrorString(e), grid);
#endif
}
```
